# Optimizing an MI355X kernel written in HIP

```python
import jax, jax.numpy as jnp
from jax import lax
import numpy as np

D_MODEL = 2048
BATCH = 2
SEQ = 4096
DEPTH = 4

MIX_A = D_MODEL // 4
MIX_B = D_MODEL // 2
MIX_C = D_MODEL // 4
GM_GROUPS = 4
GM_GROUP_W = MIX_A // GM_GROUPS
CHUNK = 128
RWKV_HEAD = 64
RWKV_HEADS = MIX_B // RWKV_HEAD
DECAY_LORA = 96
ICLR_LORA = 96
GATE_LORA = 256
RWKV_COLS = 3 * MIX_B + DECAY_LORA + ICLR_LORA + GATE_LORA
CONV_K = 3
CONV_GROUPS = 8
CONV_GROUP_W = MIX_C // CONV_GROUPS
N_IN = 2 * MIX_A + RWKV_COLS + 3 * MIX_C
D_FF = 4 * D_MODEL
RMS_EPS = 1e-6
LNX_EPS = 64e-5

kernel_name = "hybrid_gmlp_rwkv7_shortconv_trunk"


def rms_norm(x, gain):
    xf = x.astype(jnp.float32)
    y = xf * lax.rsqrt(jnp.mean(jnp.square(xf), axis=-1, keepdims=True) + RMS_EPS)
    return (y * gain.astype(jnp.float32)).astype(x.dtype)


def gmlp_mix(p, v_gain, ws, bs):
    b_, t_, _ = p.shape
    z = jax.nn.gelu(p)
    u, v = jnp.split(z, 2, axis=-1)
    u = u.reshape(b_, t_, GM_GROUPS, GM_GROUP_W)
    v = rms_norm(v.reshape(b_, t_, GM_GROUPS, GM_GROUP_W), v_gain.reshape(GM_GROUPS, GM_GROUP_W))
    vc = v.reshape(b_, t_ // CHUNK, CHUNK, GM_GROUPS, GM_GROUP_W)
    causal = jnp.tril(jnp.ones((CHUNK, CHUNK), dtype=bool))
    w = jnp.where(causal[None], ws, 0)
    mixed = jnp.einsum('gts,bcsgd->bctgd', w, vc) + bs.T[None, None, :, :, None]
    return u * mixed.reshape(b_, t_, GM_GROUPS, GM_GROUP_W)


def token_shift(p, mu):
    prev = jnp.pad(p, ((0, 0), (1, 0), (0, 0)))[:, :-1]
    return p + (prev - p) * mu


def wkv7_scan(r, w, k, v, a, b):
    b_, t_, h_, n_ = r.shape
    xs = tuple(jnp.moveaxis(t.astype(jnp.float32), 1, 0) for t in (r, w, k, v, a, b))

    def step(S, inp):
        r_t, w_t, k_t, v_t, a_t, b_t = inp
        sa = jnp.einsum('bhij,bhj->bhi', S, a_t)
        S = S * w_t[:, :, None, :] + sa[..., :, None] * b_t[..., None, :] + v_t[..., :, None] * k_t[..., None, :]
        y = jnp.einsum('bhij,bhj->bhi', S, r_t)
        return S, y

    S0 = jnp.zeros((b_, h_, n_, n_), jnp.float32)
    _, ys = lax.scan(step, S0, xs)
    return jnp.moveaxis(ys, 0, 1)


def rwkv7_mix(p, mu, w0, w_up, a0, a_up, g_up, k_k, k_a, r_k, ln_w, ln_b):
    b_, t_, _ = p.shape
    p = token_shift(p, mu)
    idx = [MIX_B, 2 * MIX_B, 3 * MIX_B, 3 * MIX_B + DECAY_LORA, 3 * MIX_B + DECAY_LORA + ICLR_LORA]
    r, k, v, wd, ad, gd = jnp.split(p, idx, axis=-1)
    w = -jax.nn.softplus(-(w0 + jnp.tanh(wd) @ w_up)) - 0.5
    decay = jnp.exp(-jnp.exp(w.astype(jnp.float32)))
    a = jax.nn.sigmoid(a0 + ad @ a_up)
    g = jax.nn.sigmoid(gd) @ g_up
    heads = lambda t: t.reshape(b_, t_, RWKV_HEADS, RWKV_HEAD)
    kkf = heads(k * k_k).astype(jnp.float32)
    kk = kkf / jnp.maximum(jnp.sqrt(jnp.sum(jnp.square(kkf), axis=-1, keepdims=True)), 1e-12)
    k = k * (1 + (a - 1) * k_a)
    rh, kh, vh, ah = heads(r), heads(k), heads(v), heads(a)
    y = wkv7_scan(rh, heads(decay), kh, vh, -kk, kk * ah.astype(jnp.float32))
    mean = jnp.mean(y, axis=-1, keepdims=True)
    var = jnp.mean(jnp.square(y - mean), axis=-1, keepdims=True)
    y = (y - mean) * lax.rsqrt(var + LNX_EPS)
    y = (y * ln_w.reshape(RWKV_HEADS, RWKV_HEAD) + ln_b.reshape(RWKV_HEADS, RWKV_HEAD)).astype(p.dtype)
    bonus = jnp.sum(rh * kh * r_k, axis=-1, keepdims=True) * vh
    return ((y + bonus) * heads(g)).reshape(b_, t_, MIX_B)


def short_conv_mix(p, conv_w):
    gb, gc, h = jnp.split(p, 3, axis=-1)
    z = gc * h
    zc = lax.conv_general_dilated(z, conv_w[:, None, :], window_strides=(1,), padding=[(CONV_K - 1, 0)],
                                  dimension_numbers=('NWC', 'WIO', 'NWC'), feature_group_count=MIX_C)
    return gb * zc


def setup_inputs(seed: int = 0) -> dict:
    key = jax.random.key(seed)
    ks = iter(jax.random.split(key, 40))
    L = DEPTH
    f32 = jnp.float32

    def normal(shape, scale):
        return jax.random.normal(next(ks), shape, f32) * scale

    def gain(shape):
        return 1.0 + normal(shape, 0.02)

    def unif(shape, lo, hi):
        return jax.random.uniform(next(ks), shape, f32, lo, hi)

    return {
        "x": normal((BATCH, SEQ, D_MODEL), 1.0),
        "norm_mix_pre": gain((L, D_MODEL)),
        "norm_mix_post": gain((L, D_MODEL)),
        "norm_mlp_pre": gain((L, D_MODEL)),
        "norm_mlp_post": gain((L, D_MODEL)),
        "w_in": normal((L, D_MODEL, N_IN), D_MODEL ** -0.5),
        "gm_v_gain": gain((L, MIX_A)),
        "gm_ws": normal((L, GM_GROUPS, CHUNK, CHUNK), CHUNK ** -0.5),
        "gm_bs": gain((L, GM_GROUPS, CHUNK)),
        "gm_out_gain": gain((L, MIX_A)),
        "rk_mu": unif((L, RWKV_COLS), 0.0, 1.0),
        "rk_w0": unif((L, MIX_B), -5.0, -1.0),
        "rk_w_up": normal((L, DECAY_LORA, MIX_B), 0.5 * DECAY_LORA ** -0.5),
        "rk_a0": normal((L, MIX_B), 0.1),
        "rk_a_up": normal((L, ICLR_LORA, MIX_B), ICLR_LORA ** -0.5),
        "rk_g_up": normal((L, GATE_LORA, MIX_B), GATE_LORA ** -0.5),
        "rk_k_k": 1.0 + normal((L, MIX_B), 0.1),
        "rk_k_a": 1.0 + normal((L, MIX_B), 0.1),
        "rk_r_k": normal((L, RWKV_HEADS, RWKV_HEAD), 0.1),
        "rk_ln_w": gain((L, MIX_B)),
        "rk_ln_b": normal((L, MIX_B), 0.02),
        "sc_conv": normal((L, CONV_K, MIX_C), CONV_K ** -0.5),
        "sc_out_gain": gain((L, MIX_C)),
        "w_out": normal((L, D_MODEL, D_MODEL), D_MODEL ** -0.5),
        "mlp_up": normal((L, D_MODEL, D_FF), D_MODEL ** -0.5),
        "mlp_down": normal((L, D_FF, D_MODEL), D_FF ** -0.5),
    }


def reference(x, norm_mix_pre, norm_mix_post, norm_mlp_pre, norm_mlp_post, w_in, gm_v_gain, gm_ws, gm_bs,
              gm_out_gain, rk_mu, rk_w0, rk_w_up, rk_a0, rk_a_up, rk_g_up, rk_k_k, rk_k_a, rk_r_k, rk_ln_w,
              rk_ln_b, sc_conv, sc_out_gain, w_out, mlp_up, mlp_down):
    b_, t_, _ = x.shape
    for l in range(DEPTH):
        h = rms_norm(x, norm_mix_pre[l])
        p = h @ w_in[l]
        pa, pb, pc = jnp.split(p, [2 * MIX_A, 2 * MIX_A + RWKV_COLS], axis=-1)
        ya = rms_norm(gmlp_mix(pa, gm_v_gain[l], gm_ws[l], gm_bs[l]),
                      gm_out_gain[l].reshape(GM_GROUPS, GM_GROUP_W)).reshape(b_, t_, MIX_A)
        yb = rwkv7_mix(pb, rk_mu[l], rk_w0[l], rk_w_up[l], rk_a0[l], rk_a_up[l], rk_g_up[l], rk_k_k[l],
                       rk_k_a[l], rk_r_k[l], rk_ln_w[l], rk_ln_b[l])
        yc = rms_norm(short_conv_mix(pc, sc_conv[l]).reshape(b_, t_, CONV_GROUPS, CONV_GROUP_W),
                      sc_out_gain[l].reshape(CONV_GROUPS, CONV_GROUP_W)).reshape(b_, t_, MIX_C)
        y = jnp.concatenate([ya, yb, yc], axis=-1) @ w_out[l]
        x = x + rms_norm(y, norm_mix_post[l])
        h = rms_norm(x, norm_mlp_pre[l])
        f = jnp.square(jax.nn.relu(h @ mlp_up[l])) @ mlp_down[l]
        x = x + rms_norm(f, norm_mlp_post[l])
    return x
```

```cpp
#include <hip/hip_runtime.h>
#include <hip/hip_cooperative_groups.h>
#include <cstdio>
#include <cstdint>
namespace cg = cooperative_groups;
#pragma clang attribute push(__attribute__((target("no-packed-fp32-ops"))), apply_to = function)
namespace pg8 {
#define PG8_LAS __attribute__((address_space(3)))
typedef unsigned short bf16_t;
typedef short bf16x8 __attribute__((ext_vector_type(8)));
typedef float f32x4 __attribute__((ext_vector_type(4)));
typedef unsigned u32x4 __attribute__((ext_vector_type(4)));
constexpr int BM = 256, BK = 64, HALF = 128, HTB = HALF * BK * 2  , STAGE_BYTES = 8 * HTB, NXCD = 8, WGM = 8;

__host__ __device__ __forceinline__ int lds_byte(int r, int c) { const int st = (r >> 4) * 2 + (c >> 5), rr = r & 15, cc = c & 31, ob = rr * 64 + cc * 2; return st * 1024 + (ob ^ (((ob >> 9) & 1) << 5)); }
__host__ __device__ __forceinline__ void stage_rc(int b, int& R, int& C) { const int st = b / 1024, sb = b % 1024, swz = sb ^ (((sb >> 9) & 1) << 5); R = (st >> 1) * 16 + swz / 64; C = (st & 1) * 32 + (swz % 64) / 2; }
__host__ __device__ __forceinline__ int perm32(int rho) { const int n = rho >> 4, i = rho & 15; return 8 * (i >> 2) + 4 * n + (i & 3); }

struct Unit { int pm, pn; };
struct Gemm { const bf16_t* A; const bf16_t* Bt; int M, N, K; int nt, ksplit, koff; };

struct StaticOrder {
    int nM, nN, nwg, G, c;
    __host__ __device__ void init(int M, int N, int G_, int c_) { nM = M / BM; nN = N / BM; nwg = nM * nN; G = G_; c = c_; }
    __host__ __device__ bool next(int i, Unit& u) const {
        const long L = (long)i * G + c; if (L >= nwg) return false;
        int wgid = (int)L; { const int q = nwg / NXCD, r = nwg % NXCD, xcd = wgid % NXCD, off = wgid / NXCD; wgid = (xcd < r ? xcd * (q + 1) : r * (q + 1) + (xcd - r) * q) + off; }
        const int nig = WGM * nN, gid = wgid / nig, fm = gid * WGM, gsz = (nM - fm) < WGM ? (nM - fm) : WGM;
        u.pm = fm + ((wgid % nig) % gsz); u.pn = (wgid % nig) / gsz; return true;
    }
    __device__ __forceinline__ void a_ready(const Unit&) const {}
    __device__ __forceinline__ void done(const Unit&) const {}
};

__device__ __forceinline__ unsigned cvt_pk_bf16(float lo, float hi) { unsigned r; asm volatile("v_cvt_pk_bf16_f32 %0, %1, %2" : "=v"(r) : "v"(lo), "v"(hi)); return r; }
typedef float f32x2 __attribute__((ext_vector_type(2)));
__device__ __forceinline__ f32x2 gelu_pk(f32x2 v) {
    const f32x2 av = __builtin_elementwise_abs(v), d = av * 0.2316418882f + 1.0f;
    f32x2 t; t.x = __builtin_amdgcn_rcpf(d.x); t.y = __builtin_amdgcn_rcpf(d.y);
    f32x2 q = t * 0.5307027145f + (-0.7265760135f); q = q * t + 0.7107068705f; q = q * t + (-0.142248368f); q = q * t + 0.127414796f; q = q * t;
    const f32x2 s = (v * v) * (-0.72134752044f);
    f32x2 e; e.x = __builtin_amdgcn_exp2f(s.x); e.y = __builtin_amdgcn_exp2f(s.y);
    const f32x2 m = v * (q * e), r = v - m;
    f32x2 o; o.x = v.x < 0.f ? m.x : r.x; o.y = v.y < 0.f ? m.y : r.y; return o;
}
struct EpiF32 {
    static constexpr bool PERM = false, AFTER_DRAIN = false;
    float* C; int ldc;
    __device__ __forceinline__ void operator()(const f32x4 (&acc)[2][2][4][2], const Unit& u, int wr, int wc, int fr, int fq) const {
        const int row0 = u.pm * BM + wr * 64 + fr, col0 = u.pn * BM + wc * 32 + 4 * fq;
#pragma unroll
        for (int ai = 0; ai < 2; ++ai)
#pragma unroll
            for (int m = 0; m < 4; ++m) { float* rowp = C + (size_t)(row0 + ai * HALF + m * 16) * ldc + col0;
#pragma unroll
                for (int bj = 0; bj < 2; ++bj)
#pragma unroll
                    for (int n = 0; n < 2; ++n) *(f32x4*)(rowp + bj * HALF + n * 16) = acc[ai][bj][m][n]; }
    }
};
struct EpiBf16 {
    static constexpr bool PERM = true, AFTER_DRAIN = false;
    bf16_t* O; int ldc; int relu2;
    __device__ __forceinline__ void operator()(const f32x4 (&acc)[2][2][4][2], const Unit& u, int wr, int wc, int fr, int fq) const {
        const int row0 = u.pm * BM + wr * 64 + fr; const int col0 = u.pn * BM + wc * 32 + 8 * fq;
#pragma unroll
        for (int ai = 0; ai < 2; ++ai)
#pragma unroll
            for (int m = 0; m < 4; ++m) { bf16_t* rowp = O + (size_t)(row0 + ai * HALF + m * 16) * ldc + col0;
#pragma unroll
                for (int bj = 0; bj < 2; ++bj) { f32x4 v0 = acc[ai][bj][m][0], v1 = acc[ai][bj][m][1];
                    if (relu2) {
#pragma unroll
                        for (int j = 0; j < 4; ++j) { const float a = fmaxf(v0[j], 0.f), b = fmaxf(v1[j], 0.f); v0[j] = a * a; v1[j] = b * b; } }
                    u32x4 w; w.x = cvt_pk_bf16(v0[0], v0[1]); w.y = cvt_pk_bf16(v0[2], v0[3]); w.z = cvt_pk_bf16(v1[0], v1[1]); w.w = cvt_pk_bf16(v1[2], v1[3]);
                    *(u32x4*)(rowp + bj * HALF) = w; } }
    }
};

template <class Epi, class Sched, bool ALIGN_EPI = false, bool SP2 = false>
__device__ __forceinline__ void gemm_phase(PG8_LAS unsigned char* lds, const Gemm g, const Sched& S, const Epi& E) {
    int tid_ = threadIdx.x; asm volatile("" : "+v"(tid_)); const int tid = tid_, wid = __builtin_amdgcn_readfirstlane(tid >> 6), lane = tid & 63, wr = wid >> 2, wc = wid & 3, fr = lane & 15, fq = lane >> 4;
    const int K = g.K, nt = g.nt ? g.nt : K / BK;
    unsigned voffA[2], voffB[2];
#pragma unroll
    for (int i = 0; i < 2; ++i) { int R, C; stage_rc(tid * 16 + i * 8192, R, C); const int Rb = Epi::PERM ? ((R & ~31) + perm32(R & 31)) : R;
        voffA[i] = (unsigned)(R * K + C) * 2u; voffB[i] = (unsigned)(Rb * K + C) * 2u; }
    const size_t kstep = (size_t)(BK * 2);
    const size_t hstep = (size_t)HALF * K * 2;
    const size_t tstep = 2 * hstep;
    const unsigned ldsw = (unsigned)wid * 1024u;
    const int aoff = lds_byte(wr * 64 + fr, fq * 8), boff = lds_byte(wc * 32 + fr, fq * 8);
#define PG8_SA(b, h) (((b) * 2 + (h)) * HTB)
#define PG8_SB(b, h) ((4 + (b) * 2 + (h)) * HTB)
#define PG8_STAGE(bufoff, gbase, voff) do { _Pragma("unroll") for (int _i = 0; _i < 2; ++_i) \
        __builtin_amdgcn_global_load_lds((const unsigned*)((const char*)(gbase) + (voff)[_i]), (PG8_LAS unsigned*)(lds + (bufoff) + ldsw + _i * 8192), 16, 0, 0); } while (0)
#define PG8_LDA(dst, b, h) do { _Pragma("unroll") for (int m = 0; m < 4; ++m) _Pragma("unroll") for (int k = 0; k < 2; ++k) dst[m][k] = *(const PG8_LAS bf16x8*)(lds + PG8_SA(b, h) + aoff + m * 2048 + k * 1024); } while (0)
#define PG8_LDB(dst, b, h) do { _Pragma("unroll") for (int n = 0; n < 2; ++n) _Pragma("unroll") for (int k = 0; k < 2; ++k) dst[n][k] = *(const PG8_LAS bf16x8*)(lds + PG8_SB(b, h) + boff + n * 2048 + k * 1024); } while (0)
#define PG8_MMA(ai, bj, At, Bt) do { __builtin_amdgcn_s_setprio(1); _Pragma("unroll") for (int m = 0; m < 4; ++m) _Pragma("unroll") for (int n = 0; n < 2; ++n) _Pragma("unroll") for (int k = 0; k < 2; ++k) \
        acc[ai][bj][m][n] = __builtin_amdgcn_mfma_f32_16x16x32_bf16(Bt[n][k], At[m][k], acc[ai][bj][m][n], 0, 0, 0); __builtin_amdgcn_s_setprio(0); } while (0)
#define PG8_WAIT_V(n) asm volatile("s_waitcnt vmcnt(" #n ")" ::: "memory")
#define PG8_WAIT_L(n) asm volatile("s_waitcnt lgkmcnt(" #n ")" ::: "memory")
#define PG8_BAR __builtin_amdgcn_s_barrier()
#define PG8_SCHED __builtin_amdgcn_sched_barrier(0)
    Unit cur, nxt; int ui = 0;
    if (!S.next(0, cur)) return;
    f32x4 acc[2][2][4][2];
#pragma unroll
    for (int a = 0; a < 2; ++a)
#pragma unroll
        for (int b = 0; b < 2; ++b)
#pragma unroll
            for (int m = 0; m < 4; ++m)
#pragma unroll
                for (int n = 0; n < 2; ++n) acc[a][b][m][n] = (f32x4){0.f, 0.f, 0.f, 0.f};
    bf16x8 At[4][2], B0[2][2], B1[2][2];
    const size_t ko0 = (cur.pn >= g.ksplit) ? (size_t)g.koff * 2 : 0;
    const char* cA = (const char*)g.A + (size_t)cur.pm * tstep + ko0; const char* cB = (const char*)g.Bt + (size_t)cur.pn * tstep + ko0;
    S.a_ready(cur);
    if constexpr (SP2) {
        PG8_STAGE(PG8_SB(0, 0), cB, voffB); PG8_STAGE(PG8_SB(0, 1), cB + hstep, voffB); PG8_STAGE(PG8_SA(0, 0), cA, voffA); PG8_STAGE(PG8_SA(0, 1), cA + hstep, voffA);
        if (wr == 1) PG8_BAR;
        PG8_WAIT_V(2); PG8_BAR;
        PG8_STAGE(PG8_SB(1, 0), cB + kstep, voffB); PG8_STAGE(PG8_SA(1, 0), cA + kstep, voffA); PG8_STAGE(PG8_SB(1, 1), cB + hstep + kstep, voffB);
        PG8_WAIT_V(6); PG8_BAR;
    } else {
        PG8_STAGE(PG8_SB(0, 0), cB, voffB); PG8_STAGE(PG8_SA(0, 0), cA, voffA); PG8_STAGE(PG8_SB(0, 1), cB + hstep, voffB); PG8_STAGE(PG8_SA(0, 1), cA + hstep, voffA);
        if (wr == 1) PG8_BAR;
        PG8_WAIT_V(4); PG8_BAR;
        PG8_STAGE(PG8_SB(1, 0), cB + kstep, voffB); PG8_STAGE(PG8_SA(1, 0), cA + kstep, voffA); PG8_STAGE(PG8_SB(1, 1), cB + hstep + kstep, voffB);
        PG8_WAIT_V(6); PG8_BAR;
    }
    for (;;) {
        const bool has_next = S.next(ui + 1, nxt);
        const size_t ko1 = (has_next && nxt.pn >= g.ksplit) ? (size_t)g.koff * 2 : 0;
        const char* nA = has_next ? (const char*)g.A + (size_t)nxt.pm * tstep + ko1 : cA; const char* nB = has_next ? (const char*)g.Bt + (size_t)nxt.pn * tstep + ko1 : cB;
        for (int t = 0; t < nt; t += 2) {
            const bool last = (t == nt - 2);
            const char* a1 = cA + (size_t)(t + 1) * kstep;
            const char* a2 = last ? nA : cA + (size_t)(t + 2) * kstep; const char* b2 = last ? nB : cB + (size_t)(t + 2) * kstep;
            const char* a3 = a2 + kstep; const char* b3 = b2 + kstep;
            if (last && has_next) S.a_ready(nxt);
            if constexpr (SP2) {
            PG8_LDB(B0, 0, 0); PG8_LDB(B1, 0, 1); PG8_SCHED; PG8_LDA(At, 0, 0); PG8_STAGE(PG8_SA(1, 1), a1 + hstep, voffA);
            PG8_WAIT_V(8); PG8_WAIT_L(0); PG8_BAR; PG8_MMA(0, 0, At, B0); PG8_MMA(0, 1, At, B1); PG8_BAR; PG8_SCHED;
            PG8_LDA(At, 0, 1); PG8_STAGE(PG8_SB(0, 0), b2, voffB); PG8_STAGE(PG8_SB(0, 1), b2 + hstep, voffB); PG8_STAGE(PG8_SA(0, 0), a2, voffA);
            PG8_WAIT_V(8); PG8_WAIT_L(0); PG8_BAR; PG8_MMA(1, 0, At, B0); PG8_MMA(1, 1, At, B1); PG8_BAR; PG8_SCHED;
            PG8_LDB(B0, 1, 0); PG8_LDB(B1, 1, 1); PG8_SCHED; PG8_LDA(At, 1, 0); PG8_STAGE(PG8_SA(0, 1), a2 + hstep, voffA);
            PG8_WAIT_V(8); PG8_WAIT_L(0); PG8_BAR; PG8_MMA(0, 0, At, B0); PG8_MMA(0, 1, At, B1); PG8_BAR; PG8_SCHED;
            PG8_LDA(At, 1, 1); PG8_STAGE(PG8_SB(1, 0), b3, voffB); PG8_STAGE(PG8_SB(1, 1), b3 + hstep, voffB); PG8_STAGE(PG8_SA(1, 0), a3, voffA);
            PG8_WAIT_V(8); PG8_WAIT_L(0); PG8_BAR; PG8_MMA(1, 0, At, B0); PG8_MMA(1, 1, At, B1); PG8_BAR; PG8_SCHED;
            } else {
            PG8_LDB(B0, 0, 0); PG8_SCHED; PG8_LDA(At, 0, 0); PG8_STAGE(PG8_SA(1, 1), a1 + hstep, voffA);
            PG8_WAIT_L(8); PG8_BAR; PG8_WAIT_L(0); PG8_MMA(0, 0, At, B0); PG8_BAR; PG8_SCHED;
            PG8_LDB(B1, 0, 1); PG8_STAGE(PG8_SB(0, 0), b2, voffB);
            PG8_BAR; PG8_WAIT_L(0); PG8_MMA(0, 1, At, B1); PG8_BAR;
            PG8_LDA(At, 0, 1); PG8_STAGE(PG8_SA(0, 0), a2, voffA);
            PG8_BAR; PG8_WAIT_L(0); PG8_MMA(1, 0, At, B0); PG8_BAR; PG8_SCHED;
            PG8_STAGE(PG8_SB(0, 1), b2 + hstep, voffB);
            PG8_WAIT_V(6); PG8_BAR; PG8_MMA(1, 1, At, B1); PG8_BAR;
            PG8_LDB(B0, 1, 0); PG8_SCHED; PG8_LDA(At, 1, 0); PG8_STAGE(PG8_SA(0, 1), a2 + hstep, voffA);
            PG8_WAIT_L(8); PG8_BAR; PG8_WAIT_L(0); PG8_MMA(0, 0, At, B0); PG8_BAR; PG8_SCHED;
            PG8_LDB(B1, 1, 1); PG8_STAGE(PG8_SB(1, 0), b3, voffB);
            PG8_BAR; PG8_WAIT_L(0); PG8_MMA(0, 1, At, B1); PG8_BAR;
            PG8_LDA(At, 1, 1); PG8_STAGE(PG8_SA(1, 0), a3, voffA);
            PG8_BAR; PG8_WAIT_L(0); PG8_MMA(1, 0, At, B0); PG8_BAR; PG8_SCHED;
            PG8_STAGE(PG8_SB(1, 1), b3 + hstep, voffB);
            PG8_WAIT_V(6); PG8_BAR; PG8_MMA(1, 1, At, B1); PG8_BAR;
            }
        }
        if constexpr (ALIGN_EPI) { if (wr == 0) PG8_BAR; }
        if constexpr (!Epi::AFTER_DRAIN) { E(acc, cur, wr, wc, fr, fq); S.done(cur); }
        if (!has_next) break;
        PG8_WAIT_V(0);
#pragma unroll
        for (int a = 0; a < 2; ++a)
#pragma unroll
            for (int b = 0; b < 2; ++b)
#pragma unroll
                for (int m = 0; m < 4; ++m)
#pragma unroll
                    for (int n = 0; n < 2; ++n) acc[a][b][m][n] = (f32x4){0.f, 0.f, 0.f, 0.f};
        cur = nxt; cA = nA; cB = nB; ++ui;
        if constexpr (ALIGN_EPI) { if (wr == 1) PG8_BAR; }
    }
    PG8_WAIT_V(0);
    if constexpr (!ALIGN_EPI) { if (wr == 0) PG8_BAR; }
    PG8_BAR;
    if constexpr (Epi::AFTER_DRAIN) { E.fused(acc, cur, wr, wc, fr, fq, lds, wid, lane); S.done(cur); }
#undef PG8_SA
#undef PG8_SB
#undef PG8_STAGE
#undef PG8_LDA
#undef PG8_LDB
#undef PG8_MMA
#undef PG8_WAIT_V
#undef PG8_WAIT_L
#undef PG8_BAR
#undef PG8_SCHED
}
}
#define LAS __attribute__((address_space(3)))
typedef unsigned short bf16;
typedef float f32x4 __attribute__((ext_vector_type(4)));
typedef float f32x2v __attribute__((ext_vector_type(2)));
typedef unsigned u32x4v __attribute__((ext_vector_type(4)));
typedef unsigned u32x2v __attribute__((ext_vector_type(2)));
typedef short bf16x8 __attribute__((ext_vector_type(8)));

constexpr int NB = 2, T = 4096, M = NB * T, D = 2048, L = 4;
constexpr int MIXA = 512, MIXB = 1024, MIXC = 512, NIN = 6080, NP = 6144, FF = 8192;
constexpr int RW0 = 1024;
constexpr int PC0 = 1024 + 3520;
constexpr int NLORA = 3072, KLORA = 512;
constexpr int NPH = 11;
constexpr int NWAVES = 8;
constexpr int LDS_BYTES = 147456;
constexpr float RMS_EPS = 1e-6f, LNX_EPS = 64e-5f;

constexpr size_t MiB = 1u << 20;
constexpr size_t WS_WIN = 0;
constexpr size_t WS_WOUT = WS_WIN + 96 * MiB;
constexpr size_t WS_WUP = WS_WOUT + 32 * MiB;
constexpr size_t WS_WDN = WS_WUP + 128 * MiB;
constexpr size_t WS_WLORA = WS_WDN + 128 * MiB;
constexpr size_t WS_XB = WS_WLORA + 12 * MiB;
constexpr size_t WS_Y = WS_XB + 32 * MiB;
constexpr size_t WS_MIX = WS_Y + 64 * MiB;
constexpr size_t WS_P = WS_MIX + 32 * MiB;
constexpr size_t WS_ALORA = WS_P + 96 * MiB;
constexpr size_t WS_LORA = WS_ALORA + 8 * MiB;
constexpr size_t WS_SCANIN = WS_LORA + 96 * MiB;
constexpr size_t WS_U = WS_SCANIN;
constexpr size_t WS_SV = WS_SCANIN + 160 * MiB;
constexpr size_t WS_SC = WS_SV + 32 * MiB;
constexpr size_t WS_SB = WS_SC + 3 * MiB;
constexpr size_t WS_YS = WS_SB + 1 * MiB;
constexpr size_t WS_CTL = WS_YS + 32 * MiB;
constexpr size_t CTL_BYTES = 65536;
constexpr size_t WS_XR = WS_CTL + 1 * MiB;
constexpr size_t WS_END = WS_XR + 32 * MiB;
constexpr int LDS_BAR_OFF = LDS_BYTES - 16;

struct Params { const float* in[26]; float* out; unsigned char* ws; int ph_lo, ph_hi; };
enum { I_X = 0, I_NMIXPRE, I_NMIXPOST, I_NMLPPRE, I_NMLPPOST, I_WIN, I_GMVG, I_GMWS, I_GMBS, I_GMOG, I_MU, I_W0, I_WUP, I_A0, I_AUP, I_GUP,
       I_KK, I_KA, I_RK, I_LNW, I_LNB, I_CONV, I_SCOG, I_WOUT, I_MUP, I_MDN };

__device__ __forceinline__ float bf2f(bf16 b) { return __builtin_bit_cast(float, ((unsigned)b) << 16); }
__device__ __forceinline__ unsigned f2bf(float f) { unsigned u = __builtin_bit_cast(unsigned, f); return (u + 0x7fffu + ((u >> 16) & 1u)) >> 16; }
__device__ __forceinline__ unsigned pk2(float lo, float hi) { unsigned r; asm volatile("v_cvt_pk_bf16_f32 %0, %1, %2" : "=v"(r) : "v"(lo), "v"(hi)); return r; }
__device__ __forceinline__ float lo16(unsigned u) { return __builtin_bit_cast(float, u << 16); }
__device__ __forceinline__ float hi16(unsigned u) { return __builtin_bit_cast(float, u & 0xffff0000u); }
template <int CTRL> __device__ __forceinline__ float dppf(float v) {
    return __builtin_bit_cast(float, __builtin_amdgcn_update_dpp(0, __builtin_bit_cast(int, v), CTRL, 0xF, 0xF, true));
}
__device__ __forceinline__ float row16_sum(float v) {
    v += dppf<0xB1>(v); v += dppf<0x4E>(v); v += dppf<0x124>(v); v += dppf<0x128>(v);
    return v;
}
__device__ __forceinline__ float wave_sum(float v) {
    v = row16_sum(v);
    const int iv = __builtin_bit_cast(int, v);
    const float a = __builtin_bit_cast(float, __builtin_amdgcn_readlane(iv, 0)), b = __builtin_bit_cast(float, __builtin_amdgcn_readlane(iv, 16));
    const float c = __builtin_bit_cast(float, __builtin_amdgcn_readlane(iv, 32)), d = __builtin_bit_cast(float, __builtin_amdgcn_readlane(iv, 48));
    return (a + b) + (c + d);
}
__device__ __forceinline__ float sigmoidf_(float x) { return 1.f / (1.f + __expf(-x)); }
__device__ __forceinline__ float gelu_tanh(float x) {
    const float u = 1.5957691216057308f * (x + 0.044715f * x * x * x);
    return x * __builtin_amdgcn_rcpf(1.f + __expf(-u));
}

struct TrItem { const float* W; bf16* WT; int K, N, k0, n0; };
__device__ __forceinline__ void tr_load(const TrItem& t, f32x4 (&v)[16], int lane) {
    const int lr = lane >> 4, lc = (lane & 15) * 4;
#pragma unroll
    for (int i = 0; i < 16; ++i) v[i] = *(const f32x4*)(t.W + (size_t)(t.k0 + 4 * i + lr) * t.N + t.n0 + lc);
}
__device__ __forceinline__ void tr_store(const TrItem& t, const f32x4 (&v)[16], LAS float* scr, int lane) {
    const int lr = lane >> 4, lc = (lane & 15) * 4;
#pragma unroll
    for (int i = 0; i < 16; ++i) { LAS float* s = scr + (4 * i + lr) * 65 + lc; s[0] = v[i][0]; s[1] = v[i][1]; s[2] = v[i][2]; s[3] = v[i][3]; }
    asm volatile("s_waitcnt lgkmcnt(0)" ::: "memory");
    const int c = lane & 7;
#pragma unroll
    for (int j = 0; j < 8; ++j) { const int n = (lane >> 3) + 8 * j; const LAS float* s = scr + (8 * c) * 65 + n;
        u32x4v o; o.x = pk2(s[0 * 65], s[1 * 65]); o.y = pk2(s[2 * 65], s[3 * 65]); o.z = pk2(s[4 * 65], s[5 * 65]); o.w = pk2(s[6 * 65], s[7 * 65]);
        *(u32x4v*)(t.WT + (size_t)(t.n0 + n) * t.K + t.k0 + 8 * c) = o; }
    asm volatile("s_waitcnt lgkmcnt(0)" ::: "memory");
}

constexpr int TR_I_IN = (D / 64) * (NIN / 64), TR_I_O = (D / 64) * (D / 64), TR_I_U = (D / 64) * (FF / 64), TR_I_D = (FF / 64) * (D / 64);
constexpr int TR_PER_L = TR_I_IN + TR_I_O + TR_I_U + TR_I_D;
__device__ __forceinline__ TrItem tr_decode(const Params& P, int it) {
    unsigned char* ws = P.ws;
    const int l = it / TR_PER_L; int r = it % TR_PER_L; TrItem t;
    if (r < TR_I_IN) { t.W = P.in[I_WIN] + (size_t)l * D * NIN; t.WT = (bf16*)(ws + WS_WIN) + (size_t)l * NP * D; t.K = D; t.N = NIN; t.k0 = 64 * (r / (NIN / 64)); t.n0 = 64 * (r % (NIN / 64)); }
    else if ((r -= TR_I_IN) < TR_I_O) { t.W = P.in[I_WOUT] + (size_t)l * D * D; t.WT = (bf16*)(ws + WS_WOUT) + (size_t)l * D * D; t.K = D; t.N = D; t.k0 = 64 * (r / (D / 64)); t.n0 = 64 * (r % (D / 64)); }
    else if ((r -= TR_I_O) < TR_I_U) { t.W = P.in[I_MUP] + (size_t)l * D * FF; t.WT = (bf16*)(ws + WS_WUP) + (size_t)l * FF * D; t.K = D; t.N = FF; t.k0 = 64 * (r / (FF / 64)); t.n0 = 64 * (r % (FF / 64)); }
    else { r -= TR_I_U; t.W = P.in[I_MDN] + (size_t)l * FF * D; t.WT = (bf16*)(ws + WS_WDN) + (size_t)l * D * FF; t.K = FF; t.N = D; t.k0 = 64 * (r / (D / 64)); t.n0 = 64 * (r % (D / 64)); }
    return t;
}
__device__ __forceinline__ void tr_slab_load(const TrItem& t, f32x4 (&v)[4], int lane) {
    const int lr = lane >> 4, lc = (lane & 15) * 4;
#pragma unroll
    for (int i = 0; i < 4; ++i) v[i] = *(const f32x4*)(t.W + (size_t)(t.k0 + 4 * i + lr) * t.N + t.n0 + lc);
}
__device__ __forceinline__ void tr_slab_store(const TrItem& t, const f32x4 (&v)[4], LAS float* scr, int lane) {
    const int lr = lane >> 4, lc = (lane & 15) * 4;
#pragma unroll
    for (int i = 0; i < 4; ++i) { LAS float* s = scr + (4 * i + lr) * 65 + lc; s[0] = v[i][0]; s[1] = v[i][1]; s[2] = v[i][2]; s[3] = v[i][3]; }
    asm volatile("s_waitcnt lgkmcnt(0)" ::: "memory");
    const LAS float* s = scr + lane;
    u32x4v o0, o1;
    o0.x = pk2(s[0 * 65], s[1 * 65]); o0.y = pk2(s[2 * 65], s[3 * 65]); o0.z = pk2(s[4 * 65], s[5 * 65]); o0.w = pk2(s[6 * 65], s[7 * 65]);
    o1.x = pk2(s[8 * 65], s[9 * 65]); o1.y = pk2(s[10 * 65], s[11 * 65]); o1.z = pk2(s[12 * 65], s[13 * 65]); o1.w = pk2(s[14 * 65], s[15 * 65]);
    bf16* dst = t.WT + (size_t)(t.n0 + lane) * t.K + t.k0;
    *(u32x4v*)dst = o0; *(u32x4v*)(dst + 8) = o1;
    asm volatile("s_waitcnt lgkmcnt(0)" ::: "memory");
}

__device__ __forceinline__ void rms_row_to_bf16(const float* xrow, const float* gain, bf16* orow, int lane) {
    f32x4 v[8]; float s = 0.f;
#pragma unroll
    for (int j = 0; j < 8; ++j) { v[j] = ((const f32x4*)xrow)[lane + 64 * j]; s += (v[j][0] * v[j][0] + v[j][1] * v[j][1]) + (v[j][2] * v[j][2] + v[j][3] * v[j][3]); }
    const float inv = rsqrtf(wave_sum(s) * (1.f / D) + RMS_EPS);
#pragma unroll
    for (int j = 0; j < 8; ++j) { const f32x4 g = ((const f32x4*)gain)[lane + 64 * j];
        u32x2v o; o.x = pk2(v[j][0] * inv * g[0], v[j][1] * inv * g[1]); o.y = pk2(v[j][2] * inv * g[2], v[j][3] * inv * g[3]);
        ((u32x2v*)orow)[lane + 64 * j] = o; }
}

__device__ __forceinline__ void phase0(const Params& P, LAS unsigned char* lds, int wave, int lane) {
    unsigned char* ws = P.ws;
    LAS float* scr = (LAS float*)(lds + wave * 16640);
    const int gw = blockIdx.x * NWAVES + wave, NGW = gridDim.x * NWAVES;
    const int n_items = ((int)gridDim.x * 4 * (T / 32) >= 4 * TR_PER_L) ? TR_PER_L : L * TR_PER_L;
    if (gw < n_items) {
        TrItem cur = tr_decode(P, gw); f32x4 va[16]; tr_load(cur, va, lane);
        for (int it = gw; it < n_items; it += NGW) {
            const bool more = (it + NGW < n_items);
            const TrItem nxt = tr_decode(P, more ? it + NGW : it);
            f32x4 vb[16]; tr_load(nxt, vb, lane);
            tr_store(cur, va, scr, lane);
            cur = nxt;
#pragma unroll
            for (int i = 0; i < 16; ++i) va[i] = vb[i];
        }
    }
    const int gt = blockIdx.x * 512 + threadIdx.x, NGT = gridDim.x * 512;
    for (int i = gt; i < L * (NP - NIN) * D / 8; i += NGT) { const int l = i / ((NP - NIN) * D / 8), r = i % ((NP - NIN) * D / 8);
        ((u32x4v*)((bf16*)(ws + WS_WIN) + (size_t)l * NP * D + (size_t)NIN * D))[r] = (u32x4v){0u, 0u, 0u, 0u}; }
    for (int i = gt; i < L * NLORA * KLORA; i += NGT) {
        const int l = i / (NLORA * KLORA), r = i % (NLORA * KLORA), n = r / KLORA, k = r % KLORA; float v = 0.f;
        if (n < 1024) { if (k < 96) v = P.in[I_WUP][((size_t)l * 96 + k) * 1024 + n]; }
        else if (n < 2048) { if (k >= 96 && k < 192) v = P.in[I_AUP][((size_t)l * 96 + (k - 96)) * 1024 + (n - 1024)]; }
        else { if (k >= 192 && k < 448) v = P.in[I_GUP][((size_t)l * 256 + (k - 192)) * 1024 + (n - 2048)]; }
        ((bf16*)(ws + WS_WLORA))[i] = (bf16)f2bf(v);
    }
    for (int m = gw; m < M; m += NGW) rms_row_to_bf16(P.in[I_X] + (size_t)m * D, P.in[I_NMIXPRE], (bf16*)(ws + WS_XB) + (size_t)m * D, lane);
}

__device__ __forceinline__ void gmlp_unit(const Params& P, int l, int unit, LAS unsigned char* lds, int wave, int lane) {
    const int g = unit & 3, bc = unit >> 2; const int m0 = bc * 128;
    const bf16* Pp = (const bf16*)(P.ws + WS_P);
    bf16* MIX = (bf16*)(P.ws + WS_MIX);
    constexpr int VS = 136;
    LAS bf16* vT = (LAS bf16*)lds;
    const float* vg = P.in[I_GMVG] + l * MIXA + g * 128;
    const int fr = lane & 15, fq = lane >> 4, t0 = wave * 16;
    const float* Wg = P.in[I_GMWS] + ((size_t)(l * 4 + g) * 128) * 128;
    f32x4 wpre[4][2];
#pragma unroll
    for (int kk = 0; kk < 4; ++kk) { const int kq = (32 * kk <= t0 + 15) ? kk : 0; const float* wp = Wg + (t0 + fr) * 128 + 32 * kq + fq * 8;
        wpre[kk][0] = *(const f32x4*)wp; wpre[kk][1] = *(const f32x4*)(wp + 4); }
    {
        const float g0 = vg[2 * lane], g1 = vg[2 * lane + 1];
        unsigned pvv[16];
#pragma unroll
        for (int i = 0; i < 16; ++i) pvv[i] = *(const unsigned*)(Pp + (size_t)(m0 + wave * 16 + i) * NP + 512 + g * 128 + 2 * lane);
#pragma unroll
        for (int i = 0; i < 16; ++i) { const int s = wave * 16 + i;
            const unsigned pv = pvv[i];
            const float z0 = gelu_tanh(lo16(pv)), z1 = gelu_tanh(hi16(pv));
            const float inv = rsqrtf(wave_sum(z0 * z0 + z1 * z1) * (1.f / 128.f) + RMS_EPS);
            vT[(2 * lane) * VS + s] = (bf16)f2bf(z0 * inv * g0); vT[(2 * lane + 1) * VS + s] = (bf16)f2bf(z1 * inv * g1); }
    }
    __syncthreads();
    bf16 uraw[4][8];
#pragma unroll
    for (int j = 0; j < 4; ++j)
#pragma unroll
        for (int n = 0; n < 8; ++n) uraw[j][n] = Pp[(size_t)(m0 + t0 + 4 * fq + j) * NP + g * 128 + n * 16 + fr];
    f32x4 acc[8];
#pragma unroll
    for (int n = 0; n < 8; ++n) acc[n] = (f32x4){0.f, 0.f, 0.f, 0.f};
#pragma unroll
    for (int kk = 0; kk < 4; ++kk) {
        if (32 * kk > t0 + 15) continue;
        const int trow = t0 + fr, k0 = 32 * kk + fq * 8;
        const f32x4 w0 = wpre[kk][0], w1 = wpre[kk][1];
        float wv[8] = {w0[0], w0[1], w0[2], w0[3], w1[0], w1[1], w1[2], w1[3]};
        bf16x8 a;
#pragma unroll
        for (int j = 0; j < 8; ++j) a[j] = (short)f2bf((k0 + j <= trow) ? wv[j] : 0.f);
#pragma unroll
        for (int n = 0; n < 8; ++n) { const bf16x8 b = *(const LAS bf16x8*)(vT + (n * 16 + fr) * VS + k0);
            acc[n] = __builtin_amdgcn_mfma_f32_16x16x32_bf16(a, b, acc[n], 0, 0, 0); }
    }
    const float* bsg = P.in[I_GMBS] + (l * 4 + g) * 128;
    const float* og = P.in[I_GMOG] + l * MIXA + g * 128;
    float ss[4] = {0.f, 0.f, 0.f, 0.f};
#pragma unroll
    for (int j = 0; j < 4; ++j) { const int t = t0 + 4 * fq + j; const float bias = bsg[t];
#pragma unroll
        for (int n = 0; n < 8; ++n) { const float u = gelu_tanh(bf2f(uraw[j][n]));
            const float o = u * (acc[n][j] + bias); acc[n][j] = o; ss[j] += o * o; } }
#pragma unroll
    for (int j = 0; j < 4; ++j) { float s = ss[j]; s += dppf<0xB1>(s); s += dppf<0x4E>(s); s += dppf<0x124>(s); s += dppf<0x128>(s); ss[j] = rsqrtf(s * (1.f / 128.f) + RMS_EPS); }
#pragma unroll
    for (int n = 0; n < 8; ++n) { const float gn = og[n * 16 + fr];
#pragma unroll
        for (int j = 0; j < 4; ++j) { const int t = t0 + 4 * fq + j; MIX[(size_t)(m0 + t) * D + g * 128 + n * 16 + fr] = (bf16)f2bf(acc[n][j] * ss[j] * gn); } }
    __syncthreads();
}

__device__ __forceinline__ void unpack8(const u32x4v u, float (&f)[8]) {
    f[0] = lo16(u.x); f[1] = hi16(u.x); f[2] = lo16(u.y); f[3] = hi16(u.y); f[4] = lo16(u.z); f[5] = hi16(u.z); f[6] = lo16(u.w); f[7] = hi16(u.w);
}

__device__ __forceinline__ void phase_e1(const Params& P, int l, LAS unsigned char* lds, int wave, int lane) {
    for (int unit = blockIdx.x; unit < 256; unit += gridDim.x) gmlp_unit(P, l, unit, lds, wave, lane);
    const int gw = blockIdx.x * NWAVES + wave, NGW = gridDim.x * NWAVES;
    const bf16* Pp = (const bf16*)(P.ws + WS_P);
    bf16* MIX = (bf16*)(P.ws + WS_MIX);
    bf16* AL = (bf16*)(P.ws + WS_ALORA);
    {
        const float* cw = P.in[I_CONV] + (size_t)l * 3 * MIXC; const float* sg = P.in[I_SCOG] + l * MIXC;
        float w0[8], w1[8], w2[8], gn[8];
#pragma unroll
        for (int e = 0; e < 8; ++e) { w0[e] = cw[8 * lane + e]; w1[e] = cw[MIXC + 8 * lane + e]; w2[e] = cw[2 * MIXC + 8 * lane + e]; gn[e] = sg[8 * lane + e]; }
        for (int mb = gw; mb < M; mb += 2 * NGW) {
            u32x4v raw[2][7];
#pragma unroll
            for (int q = 0; q < 2; ++q) { const int m = (mb + q * NGW < M) ? mb + q * NGW : mb; const int t = m & (T - 1);
                const bf16* pr = Pp + (size_t)m * NP + PC0 + 8 * lane;
                const bf16* p1 = (t >= 1) ? pr - NP : pr; const bf16* p2 = (t >= 2) ? pr - 2 * NP : pr;
                raw[q][0] = *(const u32x4v*)pr; raw[q][1] = *(const u32x4v*)(pr + 512); raw[q][2] = *(const u32x4v*)(pr + 1024);
                raw[q][3] = *(const u32x4v*)(p1 + 512); raw[q][4] = *(const u32x4v*)(p1 + 1024); raw[q][5] = *(const u32x4v*)(p2 + 512); raw[q][6] = *(const u32x4v*)(p2 + 1024); }
#pragma unroll
            for (int q = 0; q < 2; ++q) { const int m = mb + q * NGW; if (m >= M) break; const int t = m & (T - 1);
                float gb[8], c0[8], h0[8], c1[8], h1[8], c2[8], h2[8];
                unpack8(raw[q][0], gb); unpack8(raw[q][1], c0); unpack8(raw[q][2], h0); unpack8(raw[q][3], c1); unpack8(raw[q][4], h1); unpack8(raw[q][5], c2); unpack8(raw[q][6], h2);
                const float k1 = (t >= 1) ? 1.f : 0.f, k2 = (t >= 2) ? 1.f : 0.f;
                float y[8], s = 0.f;
#pragma unroll
                for (int e = 0; e < 8; ++e) { y[e] = gb[e] * (w0[e] * k2 * (c2[e] * h2[e]) + w1[e] * k1 * (c1[e] * h1[e]) + w2[e] * (c0[e] * h0[e])); s += y[e] * y[e]; }
                s += dppf<0xB1>(s); s += dppf<0x4E>(s); s += dppf<0x141>(s);
                const float inv = rsqrtf(s * (1.f / 64.f) + RMS_EPS);
                u32x4v o; o.x = pk2(y[0] * inv * gn[0], y[1] * inv * gn[1]); o.y = pk2(y[2] * inv * gn[2], y[3] * inv * gn[3]);
                o.z = pk2(y[4] * inv * gn[4], y[5] * inv * gn[5]); o.w = pk2(y[6] * inv * gn[6], y[7] * inv * gn[7]);
                *(u32x4v*)(MIX + (size_t)m * D + 1536 + 8 * lane) = o; }
        }
    }
    {
        const float* mu = P.in[I_MU] + (size_t)l * 3520 + 3072;
        const int q0 = 8 * lane; float muv[8];
#pragma unroll
        for (int e = 0; e < 8; ++e) muv[e] = (q0 < 448) ? mu[q0 + e] : 0.f;
        for (int mb = gw; mb < M; mb += 4 * NGW) {
            u32x4v rc[4], rp[4];
#pragma unroll
            for (int q = 0; q < 4; ++q) { const int m = (mb + q * NGW < M) ? mb + q * NGW : mb; const int t = m & (T - 1);
                const bf16* pr = Pp + (size_t)m * NP + RW0 + 3072 + ((q0 < 448) ? q0 : 0);
                rc[q] = *(const u32x4v*)pr; rp[q] = *(const u32x4v*)((t >= 1) ? pr - NP : pr); }
#pragma unroll
            for (int q = 0; q < 4; ++q) { const int m = mb + q * NGW; if (m >= M) break; const int t = m & (T - 1);
                u32x4v o = (u32x4v){0u, 0u, 0u, 0u};
                if (q0 < 448) { float c[8], pv[8], f[8];
                    unpack8(rc[q], c); unpack8(rp[q], pv);
                    const float k1 = (t >= 1) ? 1.f : 0.f;
#pragma unroll
                    for (int e = 0; e < 8; ++e) { const float x = c[e] + (pv[e] * k1 - c[e]) * muv[e];
                        f[e] = (q0 < 96) ? tanhf(x) : ((q0 < 192) ? x : sigmoidf_(x)); }
                    o.x = pk2(f[0], f[1]); o.y = pk2(f[2], f[3]); o.z = pk2(f[4], f[5]); o.w = pk2(f[6], f[7]); }
                *(u32x4v*)(AL + (size_t)m * KLORA + q0) = o; }
        }
    }
}

__device__ __forceinline__ float swap16_sum(float v) {
    float a = v, b = v;
    asm volatile("s_nop 1\n\tv_permlane16_swap_b32 %0, %1" : "+v"(a), "+v"(b));
    return a + b;
}
__device__ __forceinline__ float swap32_sum(float v) {
    float a = v, b = v;
    asm volatile("s_nop 1\n\tv_permlane32_swap_b32 %0, %1" : "+v"(a), "+v"(b));
    return a + b;
}
struct E2Tok { float r, v, decay, a, kkr, kmod; };
struct E2Raw { float r0, k0, v0, wl, al; };
__device__ __forceinline__ E2Raw e2_load(const bf16* Pp, const bf16* LO, int m, int c) {
    const bf16* pr = Pp + (size_t)m * NP + RW0; const bf16* lo = LO + (size_t)m * NLORA;
    E2Raw w; w.r0 = bf2f(pr[c]); w.k0 = bf2f(pr[1024 + c]); w.v0 = bf2f(pr[2048 + c]); w.wl = bf2f(lo[c]); w.al = bf2f(lo[1024 + c]); return w;
}
__device__ __forceinline__ E2Tok e2_token(const E2Raw& w, float& r1, float& k1, float& v1, float mur, float muk, float muv, float w0c, float a0c, float kkc, float kac) {
    const float r0 = w.r0, k0 = w.k0, v0 = w.v0, wl = w.wl, al = w.al;
    E2Tok o;
    o.r = r0 + (r1 - r0) * mur; const float k = k0 + (k1 - k0) * muk; o.v = v0 + (v1 - v0) * muv;
    r1 = r0; k1 = k0; v1 = v0;
    const float z = -(w0c + wl);
    const float sp = fmaxf(z, 0.f) + __logf(1.f + __expf(-fabsf(z)));
    o.decay = __expf(-__expf(-sp - 0.5f));
    o.a = __builtin_amdgcn_rcpf(1.f + __expf(-(a0c + al)));
    o.kkr = k * kkc;
    o.kmod = k * (1.f + (o.a - 1.f) * kac);
    return o;
}
__device__ __forceinline__ float sum4(float q0, float q1, float q2, float q3, bool o1, bool o2) {
    const float u01 = (o1 ? q1 : q0) + dppf<0xB1>(o1 ? q0 : q1);
    const float u23 = (o1 ? q3 : q2) + dppf<0xB1>(o1 ? q2 : q3);
    float u = (o2 ? u23 : u01) + dppf<0x4E>(o2 ? u01 : u23);
    u += dppf<0x124>(u); u += dppf<0x128>(u);
    u = swap16_sum(u); u = swap32_sum(u);
    return u;
}
__device__ __forceinline__ void phase_e2(const Params& P, int l, int wave, int lane) {
    const int gw = blockIdx.x * NWAVES + wave, NGW = gridDim.x * NWAVES;
    const bf16* Pp = (const bf16*)(P.ws + WS_P);
    const bf16* LO = (const bf16*)(P.ws + WS_LORA);
    float* SI = (float*)(P.ws + WS_SCANIN); float* SV = (float*)(P.ws + WS_SV); float* SC = (float*)(P.ws + WS_SC); float* SB = (float*)(P.ws + WS_SB);
    const float* mu = P.in[I_MU] + (size_t)l * 3520;
    const bool o1 = (lane & 1) != 0, o2 = (lane & 2) != 0;
    for (int wt = gw; wt < (M / 64) * 16; wt += NGW) {
        const int h = wt & 15, m0 = (wt >> 4) * 64, c = h * 64 + lane, b = m0 >> 12;
        const float mur = mu[c], muk = mu[1024 + c], muv = mu[2048 + c];
        const float w0c = P.in[I_W0][l * MIXB + c], a0c = P.in[I_A0][l * MIXB + c], kkc = P.in[I_KK][l * MIXB + c], kac = P.in[I_KA][l * MIXB + c], rkc = P.in[I_RK][l * MIXB + c];
        float r1 = 0.f, k1 = 0.f, v1 = 0.f;
        if ((m0 & (T - 1)) != 0) { const bf16* pp = Pp + (size_t)(m0 - 1) * NP + RW0; r1 = bf2f(pp[c]); k1 = bf2f(pp[1024 + c]); v1 = bf2f(pp[2048 + c]); }
        const size_t row0 = (size_t)(b * 16 + h) * T + (m0 & (T - 1));
        E2Raw pa0 = e2_load(Pp, LO, m0, c), pa1 = e2_load(Pp, LO, m0 + 1, c), pb0 = e2_load(Pp, LO, m0 + 2, c), pb1 = e2_load(Pp, LO, m0 + 3, c);
        for (int i = 0; i < 64; i += 2) {
            const int m = m0 + i;
            const int mn = (i + 4 < 64) ? m + 4 : m;
            const E2Raw pc0 = e2_load(Pp, LO, mn, c), pc1 = e2_load(Pp, LO, mn + 1, c);
            const E2Tok A = e2_token(pa0, r1, k1, v1, mur, muk, muv, w0c, a0c, kkc, kac);
            const E2Tok B = e2_token(pa1, r1, k1, v1, mur, muk, muv, w0c, a0c, kkc, kac);
            pa0 = pb0; pa1 = pb1; pb0 = pc0; pb1 = pc1;
            const float ka1 = A.kkr * A.a, ka2 = B.kkr * B.a, w2r2 = B.decay * B.r;
            const float uA = sum4(A.kkr * A.kkr, B.kkr * B.kkr, A.r * A.kmod * rkc, B.r * B.kmod * rkc, o1, o2);
            const float uB = sum4(ka1 * B.kkr, ka1 * A.r, ka1 * w2r2, ka2 * B.r, o1, o2);
            const float uC = sum4(A.kmod * B.kkr, A.kmod * A.r, A.kmod * w2r2, B.kmod * B.r, o1, o2);
            const float in1 = 1.f / fmaxf(sqrtf(dppf<0x00>(uA)), 1e-12f), in2 = 1.f / fmaxf(sqrtf(dppf<0x55>(uA)), 1e-12f);
            const float kk1 = A.kkr * in1, kk2 = B.kkr * in2, bs1 = kk1 * A.a, bs2 = kk2 * B.a, w12 = A.decay * B.decay;
            float* o = SI + ((row0 + i) >> 1) * 576;
            o[lane] = -kk1; o[64 + lane] = -(A.decay * kk2); o[128 + lane] = A.decay * A.r; o[192 + lane] = w12 * B.r; o[256 + lane] = w12;
            o[320 + lane] = bs1 * B.decay; o[384 + lane] = A.kmod * B.decay; o[448 + lane] = bs2; o[512 + lane] = B.kmod;
            SV[(row0 + i) * 64 + lane] = A.v; SV[(row0 + i + 1) * 64 + lane] = B.v;
            if (lane < 4) {
                const float sB = (lane == 0) ? -(in1 * in2) : ((lane == 3) ? in2 : in1);
                const float sC = (lane == 0) ? -in2 : 1.f;
                float* sc = SC + ((row0 + i) >> 1) * 12;
                const int ib = (lane == 0) ? 0 : ((lane == 1) ? 4 : ((lane == 2) ? 8 : 10));
                sc[ib] = uB * sB; sc[ib + 1] = uC * sC;
                if (lane < 2) { sc[2 + 4 * lane] = 0.f; sc[3 + 4 * lane] = 0.f; }
                if (lane >= 2) SB[(m + lane - 2) * 16 + h] = uA;
            }
        }
    }
}

constexpr int SCH = 32;
constexpr int SVOFF = (SCH / 2) * 576, SCOFF = SVOFF + SCH * 8;
constexpr int SBUF_F = SCOFF + (SCH / 2) * 12;
struct ScanRegs { f32x4 r[9]; f32x4 e; };
__device__ __forceinline__ void scan_issue(ScanRegs& R, const float* gvec, const float* gv, const float* gsc, int c, int lt) {
    const char* src = (const char*)(gvec + (size_t)c * (SCH / 2) * 576);
    const unsigned loff = (unsigned)lt * 16u;
#pragma unroll
    for (int i = 0; i < 9; ++i) R.r[i] = *(const f32x4*)(src + (size_t)i * 4096 + loff);
    R.e = (f32x4){0.f, 0.f, 0.f, 0.f};
    if (lt < 64) { const int tt = lt >> 1, part = lt & 1; R.e = *(const f32x4*)(gv + (size_t)(c * SCH + tt) * 64 + part * 4); }
    else if (lt < 112) { R.e = ((const f32x4*)(gsc + (size_t)c * (SCH / 2) * 12))[lt - 64]; }
}
__device__ __forceinline__ void scan_commit(const ScanRegs& R, LAS float* buf, int lt) {
#pragma unroll
    for (int i = 0; i < 9; ++i) ((LAS f32x4*)buf)[lt + 256 * i] = R.r[i];
    if (lt < 112) ((LAS f32x4*)(buf + SVOFF))[lt] = R.e;
}
constexpr int YST_OFF_B = 2 * SBUF_F * 4 + 4 * 4160;
static_assert(YST_OFF_B % 16 == 0 && YST_OFF_B + 2048 <= LDS_BAR_OFF, "scan LDS map");
__device__ __forceinline__ void scan_flush_y(LAS const float* ys, float* dst, int lane) {
    const int t = lane >> 1, hh = lane & 1;
    *(f32x4*)(dst + (size_t)t * MIXB + hh * 4) = *(LAS const f32x4*)(ys + t * 8 + hh * 4);
}
__device__ __forceinline__ void phase_scan(const Params& P, int l, LAS unsigned char* lds, int wave, int lane) {
    const float* SI = (const float*)(P.ws + WS_SCANIN); const float* SV = (const float*)(P.ws + WS_SV); const float* SC = (const float*)(P.ws + WS_SC);
    float* YS = (float*)(P.ws + WS_YS);
    const int tid = threadIdx.x;
#ifndef SCAN_ODD_LOADERS
#define SCAN_ODD_LOADERS 0
#endif
    const bool is_loader = SCAN_ODD_LOADERS ? ((wave & 1) != 0) : (wave >= 4);
    const int widx = SCAN_ODD_LOADERS ? (wave >> 1) : (wave & 3), lt = widx * 64 + lane;
    for (int task = blockIdx.x; task < 256; task += gridDim.x) {
        const int x = task & 7, s = task >> 3, bh = x * 4 + (s >> 3), q = s & 7, b = bh >> 4, h = bh & 15;
        const float* gvec = SI + (size_t)bh * (T / 2) * 576;
        const float* gv = SV + (size_t)bh * T * 64 + q * 8;
        const float* gsc = SC + (size_t)bh * (T / 2) * 12;
        LAS float* buf0 = (LAS float*)lds; LAS float* buf1 = buf0 + SBUF_F;
        ScanRegs R;
        const int lw = blockIdx.x * 4 + widx, nslab = (l + 1 < L && task < (int)gridDim.x && (int)gridDim.x * 4 * (T / SCH) >= 4 * TR_PER_L) ? 4 * TR_PER_L : 0;
        LAS float* scrw = (LAS float*)(lds + 2 * SBUF_F * 4) + widx * 1040;
        TrItem sl; f32x4 sv[4]; bool have = false;
        if (is_loader) { scan_issue(R, gvec, gv, gsc, 0, lt); scan_commit(R, buf0, lt); scan_issue(R, gvec, gv, gsc, 1, lt);
            if (lw < nslab) { sl = tr_decode(P, (l + 1) * TR_PER_L + (lw >> 2)); sl.k0 += 16 * (lw & 3); tr_slab_load(sl, sv, lane); have = true; } }
        __syncthreads();
        const int cl = lane & 31, il = widx * 2 + (lane >> 5), g8 = cl >> 2, cls = cl & 3; const bool o1 = (cl & 1) != 0, o2 = (cl & 2) != 0;
        float S0 = 0.f, S1 = 0.f, yrec = 0.f;
        const int ycoef = o1 ? 8 : 4;
        float* ybase = YS + (size_t)(b * T) * MIXB + h * 64 + q * 8;
        for (int c = 0; c < T / SCH; ++c) {
            LAS const float* cur = (c & 1) ? buf1 : buf0; LAS float* nxt = (c & 1) ? buf0 : buf1;
            LAS float* yst = (LAS float*)(lds + YST_OFF_B) + (c & 1) * 256;
            if (is_loader) { if (c + 1 < T / SCH) { scan_commit(R, nxt, lt); if (c + 2 < T / SCH) scan_issue(R, gvec, gv, gsc, c + 2, lt); }
                if (c >= 1 && widx == 0) scan_flush_y((LAS const float*)(lds + YST_OFF_B) + ((c - 1) & 1) * 256, ybase + (size_t)((c - 1) * SCH) * MIXB, lane);
                if (have) tr_slab_store(sl, sv, scrw, lane);
                const int slab = (c + 1) * (int)gridDim.x * 4 + lw; have = (c + 1 < T / SCH) && (slab < nslab);
                if (have) { sl = tr_decode(P, (l + 1) * TR_PER_L + (slab >> 2)); sl.k0 += 16 * (slab & 3); tr_slab_load(sl, sv, lane); } }
            else {
#define SCAN_LD(pp, V1, V2, V3, V4, U1, U2, U3, U4, U5, v1, v2, ca, cb) \
                LAS const float* vb_##V1 = cur + (pp) * 576 + cl * 2; \
                V1 = *(LAS const f32x2v*)(vb_##V1); V2 = *(LAS const f32x2v*)(vb_##V1 + 64); V3 = *(LAS const f32x2v*)(vb_##V1 + 128); V4 = *(LAS const f32x2v*)(vb_##V1 + 192); \
                U1 = *(LAS const f32x2v*)(vb_##V1 + 256); U2 = *(LAS const f32x2v*)(vb_##V1 + 320); U3 = *(LAS const f32x2v*)(vb_##V1 + 384); U4 = *(LAS const f32x2v*)(vb_##V1 + 448); U5 = *(LAS const f32x2v*)(vb_##V1 + 512); \
                v1 = cur[SVOFF + (2 * (pp)) * 8 + il]; v2 = cur[SVOFF + (2 * (pp) + 1) * 8 + il]; \
                ca = *(LAS const f32x2v*)(cur + SCOFF + (pp) * 12); cb = *(LAS const f32x4*)(cur + SCOFF + (pp) * 12 + ycoef);
                f32x2v V1, V2, V3, V4, U1, U2, U3, U4, U5; float v1, v2; f32x2v ca; f32x4 cb;
                { SCAN_LD(0, V1, V2, V3, V4, U1, U2, U3, U4, U5, v1, v2, ca, cb) }
#pragma unroll 8
                for (int p = 0; p < SCH / 2; ++p) {
                    const int pn = (p + 1 < SCH / 2) ? p + 1 : p;
                    f32x2v nV1, nV2, nV3, nV4, nU1, nU2, nU3, nU4, nU5; float nv1, nv2; f32x2v nca; f32x4 ncb;
                    { SCAN_LD(pn, nV1, nV2, nV3, nV4, nU1, nU2, nU3, nU4, nU5, nv1, nv2, nca, ncb) }
                    const float d0 = S0 * V1[0] + S1 * V1[1], d1 = S0 * V2[0] + S1 * V2[1], d2 = S0 * V3[0] + S1 * V3[1], d3 = S0 * V4[0] + S1 * V4[1];
                    const float t0 = v1 * U3[0] + v2 * U5[0], t1 = v1 * U3[1] + v2 * U5[1];
                    const float u01 = (o1 ? d1 : d0) + dppf<0xB1>(o1 ? d0 : d1);
                    const float u23 = (o1 ? d3 : d2) + dppf<0xB1>(o1 ? d2 : d3);
                    float u = (o2 ? u23 : u01) + dppf<0x4E>(o2 ? u01 : u23);
                    u += dppf<0x124>(u); u += dppf<0x128>(u);
                    u = swap16_sum(u);
                    const float sa1 = dppf<0x00>(u);
                    const float sa2 = dppf<0x55>(u) + sa1 * ca[0] + v1 * ca[1];
                    S0 = (S0 * U1[0] + (sa1 * U2[0] + t0)) + sa2 * U4[0];
                    S1 = (S1 * U1[1] + (sa1 * U2[1] + t1)) + sa2 * U4[1];
                    const float ysel = u + sa1 * cb[0] + v1 * cb[1] + sa2 * cb[2] + v2 * cb[3];
                    yrec = ((p & 7) == g8) ? ysel : yrec;
                    if ((p & 7) == 7) { if (o2) yst[((p & 8) * 2 + 2 * g8 + (cls - 2)) * 8 + il] = yrec; }
                    V1 = nV1; V2 = nV2; V3 = nV3; V4 = nV4; U1 = nU1; U2 = nU2; U3 = nU3; U4 = nU4; U5 = nU5; v1 = nv1; v2 = nv2; ca = nca; cb = ncb;
                }
#undef SCAN_LD
            }
            asm volatile("s_waitcnt lgkmcnt(0)" ::: "memory"); __builtin_amdgcn_s_barrier(); asm volatile("" ::: "memory");
        }
        if (is_loader && widx == 0) scan_flush_y((LAS const float*)(lds + YST_OFF_B) + ((T / SCH - 1) & 1) * 256, ybase + (size_t)((T / SCH - 1) * SCH) * MIXB, lane);
    }
}

__device__ __forceinline__ void phase_e3(const Params& P, int l, int wave, int lane) {
    const int gw = blockIdx.x * NWAVES + wave, NGW = gridDim.x * NWAVES;
    const float* YS = (const float*)(P.ws + WS_YS); const bf16* LO = (const bf16*)(P.ws + WS_LORA);
    const float* SV = (const float*)(P.ws + WS_SV); const float* SB = (const float*)(P.ws + WS_SB);
    bf16* MIX = (bf16*)(P.ws + WS_MIX);
    const bool o1 = (lane & 1) != 0, o2 = (lane & 2) != 0;
    for (int wt = gw; wt < (M / 64) * 16; wt += NGW) {
        const int h = wt & 15, m0 = (wt >> 4) * 64, c = h * 64 + lane, b = m0 >> 12;
        const float lnw = P.in[I_LNW][l * MIXB + c], lnb = P.in[I_LNB][l * MIXB + c];
        const size_t row0 = (size_t)(b * 16 + h) * T + (m0 & (T - 1));
        for (int i = 0; i < 64; i += 8) {
            float y[8], v[8], g[8], sb[8];
#pragma unroll
            for (int e = 0; e < 8; ++e) { const int m = m0 + i + e;
                y[e] = YS[(size_t)m * MIXB + c]; v[e] = SV[(row0 + i + e) * 64 + lane]; g[e] = bf2f(LO[(size_t)m * NLORA + 2048 + c]); sb[e] = SB[m * 16 + h]; }
#pragma unroll
            for (int e = 0; e < 8; e += 2) {
                const float u = sum4(y[e], y[e] * y[e], y[e + 1], y[e + 1] * y[e + 1], o1, o2);
                const float s0 = dppf<0x00>(u), q0 = dppf<0x55>(u), s1 = dppf<0xAA>(u), q1 = dppf<0xFF>(u);
                const float mean0 = s0 * (1.f / 64.f), mean1 = s1 * (1.f / 64.f);
                const float var0 = fmaxf(q0 * (1.f / 64.f) - mean0 * mean0, 0.f), var1 = fmaxf(q1 * (1.f / 64.f) - mean1 * mean1, 0.f);
                const float yn0 = (y[e] - mean0) * rsqrtf(var0 + LNX_EPS) * lnw + lnb, yn1 = (y[e + 1] - mean1) * rsqrtf(var1 + LNX_EPS) * lnw + lnb;
                MIX[(size_t)(m0 + i + e) * D + 512 + c] = (bf16)f2bf((yn0 + sb[e] * v[e]) * g[e]);
                MIX[(size_t)(m0 + i + e + 1) * D + 512 + c] = (bf16)f2bf((yn1 + sb[e + 1] * v[e + 1]) * g[e + 1]);
            }
        }
    }
}

template <bool IN_F32, bool OUT_F32>
__device__ __forceinline__ void phase_norm(const void* xin_, void* xout_, const bf16* Y, const float* g1, const float* g2, bf16* XB, int wave, int lane) {
    const int gw = blockIdx.x * NWAVES + wave, NGW = gridDim.x * NWAVES;
    const float* xin32 = (const float*)xin_; const bf16* xin16 = (const bf16*)xin_;
    f32x4 yv[8], xv[8];
    u32x2v yr[8], xr[8];
    if (gw < M) {
#pragma unroll
        for (int j = 0; j < 8; ++j) { yr[j] = ((const u32x2v*)(Y + (size_t)gw * D))[lane + 64 * j];
            if (IN_F32) xv[j] = ((const f32x4*)(xin32 + (size_t)gw * D))[lane + 64 * j]; else xr[j] = ((const u32x2v*)(xin16 + (size_t)gw * D))[lane + 64 * j]; }
    }
    for (int m = gw; m < M; m += NGW) {
        const int mn = (m + NGW < M) ? m + NGW : m;
        u32x2v ny[8], nxr[8]; f32x4 nx[8];
#pragma unroll
        for (int j = 0; j < 8; ++j) { ny[j] = ((const u32x2v*)(Y + (size_t)mn * D))[lane + 64 * j];
            if (IN_F32) nx[j] = ((const f32x4*)(xin32 + (size_t)mn * D))[lane + 64 * j]; else nxr[j] = ((const u32x2v*)(xin16 + (size_t)mn * D))[lane + 64 * j]; }
#pragma unroll
        for (int j = 0; j < 8; ++j) { yv[j] = (f32x4){lo16(yr[j].x), hi16(yr[j].x), lo16(yr[j].y), hi16(yr[j].y)};
            if (!IN_F32) xv[j] = (f32x4){lo16(xr[j].x), hi16(xr[j].x), lo16(xr[j].y), hi16(xr[j].y)}; }
        float s = 0.f;
#pragma unroll
        for (int j = 0; j < 8; ++j) s += (yv[j][0] * yv[j][0] + yv[j][1] * yv[j][1]) + (yv[j][2] * yv[j][2] + yv[j][3] * yv[j][3]);
        const float inv = rsqrtf(wave_sum(s) * (1.f / D) + RMS_EPS);
        float s2 = 0.f;
#pragma unroll
        for (int j = 0; j < 8; ++j) { const f32x4 g = ((const f32x4*)g1)[lane + 64 * j];
            yv[j] = xv[j] + yv[j] * inv * g; s2 += (yv[j][0] * yv[j][0] + yv[j][1] * yv[j][1]) + (yv[j][2] * yv[j][2] + yv[j][3] * yv[j][3]);
            if (OUT_F32) ((f32x4*)((float*)xout_ + (size_t)m * D))[lane + 64 * j] = yv[j];
            else { u32x2v o; o.x = pk2(yv[j][0], yv[j][1]); o.y = pk2(yv[j][2], yv[j][3]); ((u32x2v*)((bf16*)xout_ + (size_t)m * D))[lane + 64 * j] = o; } }
        if (g2) {
            const float inv2 = rsqrtf(wave_sum(s2) * (1.f / D) + RMS_EPS);
#pragma unroll
            for (int j = 0; j < 8; ++j) { const f32x4 g = ((const f32x4*)g2)[lane + 64 * j];
                u32x2v o; o.x = pk2(yv[j][0] * inv2 * g[0], yv[j][1] * inv2 * g[1]); o.y = pk2(yv[j][2] * inv2 * g[2], yv[j][3] * inv2 * g[3]);
                ((u32x2v*)(XB + (size_t)m * D))[lane + 64 * j] = o; }
        }
#pragma unroll
        for (int j = 0; j < 8; ++j) { yr[j] = ny[j]; if (IN_F32) xv[j] = nx[j]; else xr[j] = nxr[j]; }
    }
}

#define XB_TMO      128
#define XB_XCNT(j)  (256  + 64 * (j))
#define XB_XSUB(j)  (1280 + 64 * (j))
#define XB_XGEN(j)  (2304 + 64 * (j))
#define XB_TOP      3328
#define XB_TOPGEN   3392
#define XCD_BAR_WORDS 3456
#define XB_SPIN_CAP (1u << 18)

__device__ __forceinline__ unsigned xb_ld(unsigned* p)              { return __hip_atomic_load(p, __ATOMIC_RELAXED, __HIP_MEMORY_SCOPE_AGENT); }
__device__ __forceinline__ unsigned xb_add(unsigned* p, unsigned v) { return __hip_atomic_fetch_add(p, v, __ATOMIC_RELAXED, __HIP_MEMORY_SCOPE_AGENT); }
__device__ __forceinline__ unsigned xb_xcc_id() { return (unsigned)__builtin_amdgcn_s_getreg((3 << 11) | 20) & 0xFu; }
#define XB_SPIN(cond, bar) do { unsigned _sp = 0; while (cond) { __builtin_amdgcn_s_sleep(1); \
    if ((++_sp & 255u) == 0u) { if (xb_ld(&(bar)[XB_TMO])) break; if (_sp > XB_SPIN_CAP) { atomicAdd(&(bar)[XB_TMO], 1u); break; } } } } while (0)

struct XcdBarrier {
    unsigned* bar; unsigned x;
    volatile LAS unsigned* st;
};

__device__ __forceinline__ XcdBarrier xcd_barrier_post(unsigned* bar, volatile LAS unsigned* st) {
    XcdBarrier b; b.bar = bar; b.x = xb_xcc_id(); b.st = st;
    if (threadIdx.x == 0) (void)xb_add(&bar[XB_XCNT(b.x)], 1u);
    return b;
}
__device__ __forceinline__ void xcd_barrier_complete(unsigned* bar, unsigned x, unsigned& nloc, unsigned& nx) {
    const unsigned G = gridDim.x * gridDim.y * gridDim.z;
    unsigned sum, cnt, mine, sp = 0u;
    for (;;) {
        sum = 0u; cnt = 0u; mine = 0u;
#pragma unroll
        for (unsigned j = 0; j < 16; ++j) { const unsigned c = xb_ld(&bar[XB_XCNT(j)]); sum += c; cnt += (c > 0u) ? 1u : 0u; mine = (j == x) ? c : mine; }
        if (sum == G) break;
        __builtin_amdgcn_s_sleep(1);
        if ((++sp & 255u) == 0u) { if (xb_ld(&bar[XB_TMO])) break; if (sp > XB_SPIN_CAP) { atomicAdd(&bar[XB_TMO], 1u); break; } }
    }
    nloc = mine > 0u ? mine : 1u; nx = cnt > 0u ? cnt : 1u;
}

__device__ __forceinline__ void xcd_barrier(const XcdBarrier& b) {
    asm volatile("s_waitcnt vmcnt(0)" ::: "memory");
    __syncthreads();
    if (threadIdx.x == 0) {
        unsigned* bar = b.bar;
        __builtin_amdgcn_s_waitcnt(0);
        unsigned nloc = b.st[0], nx = b.st[1];
        if (nloc == 0u) { xcd_barrier_complete(bar, b.x, nloc, nx); b.st[0] = nloc; b.st[1] = nx; }
        const unsigned old = xb_add(&bar[XB_XSUB(b.x)], 1u);
        const unsigned gen = old / nloc;
        if (old + 1u == (gen + 1u) * nloc) {
            __builtin_amdgcn_fence(__ATOMIC_RELEASE, "agent");
            asm volatile("s_waitcnt vmcnt(0)" ::: "memory");
            const unsigned og = xb_add(&bar[XB_TOP], 1u);
            const unsigned tg = og / nx;
            if (og + 1u == (tg + 1u) * nx) xb_add(&bar[XB_TOPGEN], 1u);
            else XB_SPIN(xb_ld(&bar[XB_TOPGEN]) == tg, bar);
            __builtin_amdgcn_fence(__ATOMIC_ACQUIRE, "agent");
            xb_add(&bar[XB_XGEN(b.x)], 1u);
            asm volatile("s_waitcnt vmcnt(0)" ::: "memory");
        } else {
            XB_SPIN(xb_ld(&bar[XB_XGEN(b.x)]) == gen, bar);
            __builtin_amdgcn_fence(__ATOMIC_ACQUIRE, "agent");
            asm volatile("s_waitcnt vmcnt(0)" ::: "memory");
        }
    }
    __syncthreads();
}


template <class Epi> __device__ __forceinline__ void run_gemm(LAS unsigned char* lds, const bf16* A, const bf16* Bt, int N, int K, const Epi& E, int wnt = 0, int wks = 0x7fffffff, int wko = 0) {
    pg8::Gemm g{A, Bt, M, N, K, wnt, wks, wko}; pg8::StaticOrder S; S.init(M, N, (int)gridDim.x, (int)blockIdx.x);
    pg8::gemm_phase<Epi, pg8::StaticOrder, true, true>(lds, g, S, E);
}

__global__ void __launch_bounds__(NWAVES * 64, 2) trunk_fwd(Params P) {
    extern __shared__ __attribute__((aligned(16))) unsigned char lds_raw[];
    LAS unsigned char* lds = (LAS unsigned char*)lds_raw;
    cg::grid_group grid = cg::this_grid();
    if (threadIdx.x < 4) ((LAS unsigned*)(lds + LDS_BAR_OFF))[threadIdx.x] = 0u;
    __syncthreads();
    const XcdBarrier xbar = xcd_barrier_post((unsigned*)(P.ws + WS_CTL), (volatile LAS unsigned*)(lds + LDS_BAR_OFF));
    if (P.ph_hi - P.ph_lo > 1) grid.sync();
    unsigned char* ws = P.ws;
    for (int ph = P.ph_lo; ph < P.ph_hi; ++ph) {
        int tid = threadIdx.x; asm volatile("" : "+v"(tid));
        const int lane = tid & 63, wave = __builtin_amdgcn_readfirstlane(tid >> 6);
        if (ph == 0) phase0(P, lds, wave, lane);
        else {
            const int l = (ph - 1) / NPH, k = (ph - 1) % NPH;
            if (k == 0 || k == 8 || k == 2 || k == 6 || k == 9) {
                const bf16* A = (k == 0 || k == 8) ? (const bf16*)(ws + WS_XB) : ((k == 2) ? (const bf16*)(ws + WS_ALORA) : ((k == 6) ? (const bf16*)(ws + WS_MIX) : (const bf16*)(ws + WS_U)));
                const bf16* Bt = (k == 0) ? (const bf16*)(ws + WS_WIN) + (size_t)l * NP * D : ((k == 8) ? (const bf16*)(ws + WS_WUP) + (size_t)l * FF * D
                               : ((k == 2) ? (const bf16*)(ws + WS_WLORA) + (size_t)l * NLORA * KLORA : ((k == 6) ? (const bf16*)(ws + WS_WOUT) + (size_t)l * D * D : (const bf16*)(ws + WS_WDN) + (size_t)l * D * FF)));
                const int N = (k == 0) ? NP : ((k == 8) ? FF : ((k == 2) ? NLORA : D)), K = (k == 2) ? KLORA : ((k == 9) ? FF : D);
                bf16* O = (bf16*)(ws + ((k == 0) ? WS_P : ((k == 8) ? WS_U : ((k == 2) ? WS_LORA : WS_Y))));
                pg8::EpiBf16 E{O, N, (k == 8) ? 1 : 0};
                run_gemm(lds, A, Bt, N, K, E, (k == 2) ? 4 : 0, (k == 2) ? 8 : 0x7fffffff, (k == 2) ? 192 : 0);
            } else if (k == 1) phase_e1(P, l, lds, wave, lane);
            else if (k == 3) phase_e2(P, l, wave, lane);
            else if (k == 4) phase_scan(P, l, lds, wave, lane);
            else if (k == 5) phase_e3(P, l, wave, lane);
            else if (k == 7) { if (l == 0) phase_norm<true, false>(P.in[I_X], ws + WS_XR, (const bf16*)(ws + WS_Y), P.in[I_NMIXPOST] + l * D, P.in[I_NMLPPRE] + l * D, (bf16*)(ws + WS_XB), wave, lane);
                               else phase_norm<false, false>(ws + WS_XR, ws + WS_XR, (const bf16*)(ws + WS_Y), P.in[I_NMIXPOST] + l * D, P.in[I_NMLPPRE] + l * D, (bf16*)(ws + WS_XB), wave, lane); }
            else   { if (l + 1 < L) phase_norm<false, false>(ws + WS_XR, ws + WS_XR, (const bf16*)(ws + WS_Y), P.in[I_NMLPPOST] + l * D, P.in[I_NMIXPRE] + (l + 1) * D, (bf16*)(ws + WS_XB), wave, lane);
                                 else phase_norm<false, true>(ws + WS_XR, P.out, (const bf16*)(ws + WS_Y), P.in[I_NMLPPOST] + l * D, nullptr, (bf16*)(ws + WS_XB), wave, lane); }
        }
        if (ph + 1 < P.ph_hi) xcd_barrier(xbar);
        else if (false) {
            asm volatile("s_waitcnt vmcnt(0) lgkmcnt(0)" ::: "memory");
            __syncthreads();
            if (tid == 0) { __builtin_amdgcn_fence(__ATOMIC_RELEASE, "agent"); asm volatile("s_waitcnt vmcnt(0)" ::: "memory"); }
            grid.sync();
            if (tid == 0) { __builtin_amdgcn_fence(__ATOMIC_ACQUIRE, "agent"); asm volatile("s_waitcnt vmcnt(0)" ::: "memory"); }
            __syncthreads();
        }
    }
}

#pragma clang attribute pop
#ifndef MULTI_LAUNCH
#define MULTI_LAUNCH 0
#endif
extern "C" void kernel_launch(void* const* d_in, const int* in_sizes, int n_in, void* d_out, int out_size, void* d_ws, size_t ws_size, hipStream_t stream) {
    static int grid = 0;
    if (grid == 0) {
        int dev = 0, cus = 0, per_cu = 0;
        (void)hipGetDevice(&dev);
        (void)hipDeviceGetAttribute(&cus, hipDeviceAttributeMultiprocessorCount, dev);
        if (hipFuncSetAttribute((const void*)trunk_fwd, hipFuncAttributeMaxDynamicSharedMemorySize, LDS_BYTES) != hipSuccess) fprintf(stderr, "kernel_launch: hipFuncSetAttribute failed\n");
        if (hipOccupancyMaxActiveBlocksPerMultiprocessor(&per_cu, (const void*)trunk_fwd, NWAVES * 64, LDS_BYTES) != hipSuccess || per_cu < 1) { fprintf(stderr, "kernel_launch: occupancy query gave %d\n", per_cu); per_cu = 1; }
        (void)hipGetLastError();
        grid = cus * per_cu;
        if (n_in != 26 || ws_size < WS_END) fprintf(stderr, "kernel_launch: unexpected n_in %d / ws_size %zu (need %zu)\n", n_in, ws_size, (size_t)WS_END);
    }
    (void)hipMemsetAsync((char*)d_ws + WS_CTL, 0, CTL_BYTES, stream);
    Params p{};
    for (int i = 0; i < 26; ++i) p.in[i] = (const float*)d_in[i];
    p.out = (float*)d_out; p.ws = (unsigned char*)d_ws;
    const int nph = 1 + L * NPH;
#if MULTI_LAUNCH
    for (int ph = 0; ph < nph; ++ph) { p.ph_lo = ph; p.ph_hi = ph + 1; hipLaunchKernelGGL(trunk_fwd, dim3(grid), dim3(NWAVES * 64), LDS_BYTES, stream, p); }
#else
    p.ph_lo = 0; p.ph_hi = nph;
    void* args[] = {&p};
    hipError_t e = hipLaunchCooperativeKernel((const void*)trunk_fwd, dim3(grid), dim3(NWAVES * 64), args, LDS_BYTES, stream);
    if (e != hipSuccess) fprintf(stderr, "cooperative launch failed: %s (grid %d)\n", hipGetErrorString(e), grid);
#endif
}
```

```cpp
#include <hip/hip_runtime.h>
#include <hip/hip_cooperative_groups.h>
#include <cstdio>
#include <cstdint>
namespace cg = cooperative_groups;
#pragma clang attribute push(__attribute__((target("no-packed-fp32-ops"))), apply_to = function)
namespace pg8 {
#define PG8_LAS __attribute__((address_space(3)))
typedef unsigned short bf16_t;
typedef short bf16x8 __attribute__((ext_vector_type(8)));
typedef float f32x4 __attribute__((ext_vector_type(4)));
typedef unsigned u32x4 __attribute__((ext_vector_type(4)));
constexpr int BM = 256, BK = 64, HALF = 128, HTB = HALF * BK * 2  , STAGE_BYTES = 8 * HTB, NXCD = 8, WGM = 8;

__host__ __device__ __forceinline__ int lds_byte(int r, int c) { const int st = (r >> 4) * 2 + (c >> 5), rr = r & 15, cc = c & 31, ob = rr * 64 + cc * 2; return st * 1024 + (ob ^ (((ob >> 9) & 1) << 5)); }
__host__ __device__ __forceinline__ void stage_rc(int b, int& R, int& C) { const int st = b / 1024, sb = b % 1024, swz = sb ^ (((sb >> 9) & 1) << 5); R = (st >> 1) * 16 + swz / 64; C = (st & 1) * 32 + (swz % 64) / 2; }
__host__ __device__ __forceinline__ int perm32(int rho) { const int n = rho >> 4, i = rho & 15; return 8 * (i >> 2) + 4 * n + (i & 3); }

struct Unit { int pm, pn; };
struct Gemm { const bf16_t* A; const bf16_t* Bt; int M, N, K; int nt, ksplit, koff; };

struct StaticOrder {
    int nM, nN, nwg, G, c;
    __host__ __device__ void init(int M, int N, int G_, int c_) { nM = M / BM; nN = N / BM; nwg = nM * nN; G = G_; c = c_; }
    __host__ __device__ bool next(int i, Unit& u) const {
        const long L = (long)i * G + c; if (L >= nwg) return false;
        int wgid = (int)L; { const int q = nwg / NXCD, r = nwg % NXCD, xcd = wgid % NXCD, off = wgid / NXCD; wgid = (xcd < r ? xcd * (q + 1) : r * (q + 1) + (xcd - r) * q) + off; }
        const int nig = WGM * nN, gid = wgid / nig, fm = gid * WGM, gsz = (nM - fm) < WGM ? (nM - fm) : WGM;
        u.pm = fm + ((wgid % nig) % gsz); u.pn = (wgid % nig) / gsz; return true;
    }
    __device__ __forceinline__ void a_ready(const Unit&) const {}
    __device__ __forceinline__ void done(const Unit&) const {}
};

__device__ __forceinline__ unsigned cvt_pk_bf16(float lo, float hi) { unsigned r; asm volatile("v_cvt_pk_bf16_f32 %0, %1, %2" : "=v"(r) : "v"(lo), "v"(hi)); return r; }
typedef float f32x2 __attribute__((ext_vector_type(2)));
__device__ __forceinline__ f32x2 gelu_pk(f32x2 v) {
    const f32x2 av = __builtin_elementwise_abs(v), d = av * 0.2316418882f + 1.0f;
    f32x2 t; t.x = __builtin_amdgcn_rcpf(d.x); t.y = __builtin_amdgcn_rcpf(d.y);
    f32x2 q = t * 0.5307027145f + (-0.7265760135f); q = q * t + 0.7107068705f; q = q * t + (-0.142248368f); q = q * t + 0.127414796f; q = q * t;
    const f32x2 s = (v * v) * (-0.72134752044f);
    f32x2 e; e.x = __builtin_amdgcn_exp2f(s.x); e.y = __builtin_amdgcn_exp2f(s.y);
    const f32x2 m = v * (q * e), r = v - m;
    f32x2 o; o.x = v.x < 0.f ? m.x : r.x; o.y = v.y < 0.f ? m.y : r.y; return o;
}
struct EpiF32 {
    static constexpr bool PERM = false, AFTER_DRAIN = false;
    float* C; int ldc;
    __device__ __forceinline__ void operator()(const f32x4 (&acc)[2][2][4][2], const Unit& u, int wr, int wc, int fr, int fq) const {
        const int row0 = u.pm * BM + wr * 64 + fr, col0 = u.pn * BM + wc * 32 + 4 * fq;
#pragma unroll
        for (int ai = 0; ai < 2; ++ai)
#pragma unroll
            for (int m = 0; m < 4; ++m) { float* rowp = C + (size_t)(row0 + ai * HALF + m * 16) * ldc + col0;
#pragma unroll
                for (int bj = 0; bj < 2; ++bj)
#pragma unroll
                    for (int n = 0; n < 2; ++n) *(f32x4*)(rowp + bj * HALF + n * 16) = acc[ai][bj][m][n]; }
    }
};
struct EpiBf16 {
    static constexpr bool PERM = true, AFTER_DRAIN = false;
    bf16_t* O; int ldc; int relu2;
    __device__ __forceinline__ void operator()(const f32x4 (&acc)[2][2][4][2], const Unit& u, int wr, int wc, int fr, int fq) const {
        const int row0 = u.pm * BM + wr * 64 + fr; const int col0 = u.pn * BM + wc * 32 + 8 * fq;
#pragma unroll
        for (int ai = 0; ai < 2; ++ai)
#pragma unroll
            for (int m = 0; m < 4; ++m) { bf16_t* rowp = O + (size_t)(row0 + ai * HALF + m * 16) * ldc + col0;
#pragma unroll
                for (int bj = 0; bj < 2; ++bj) { f32x4 v0 = acc[ai][bj][m][0], v1 = acc[ai][bj][m][1];
                    if (relu2) {
#pragma unroll
                        for (int j = 0; j < 4; ++j) { const float a = fmaxf(v0[j], 0.f), b = fmaxf(v1[j], 0.f); v0[j] = a * a; v1[j] = b * b; } }
                    u32x4 w; w.x = cvt_pk_bf16(v0[0], v0[1]); w.y = cvt_pk_bf16(v0[2], v0[3]); w.z = cvt_pk_bf16(v1[0], v1[1]); w.w = cvt_pk_bf16(v1[2], v1[3]);
                    *(u32x4*)(rowp + bj * HALF) = w; } }
    }
};

template <class Epi, class Sched, bool ALIGN_EPI = false, bool SP2 = false>
__device__ __forceinline__ void gemm_phase(PG8_LAS unsigned char* lds, const Gemm g, const Sched& S, const Epi& E) {
    int tid_ = threadIdx.x; asm volatile("" : "+v"(tid_)); const int tid = tid_, wid = __builtin_amdgcn_readfirstlane(tid >> 6), lane = tid & 63, wr = wid >> 2, wc = wid & 3, fr = lane & 15, fq = lane >> 4;
    const int K = g.K, nt = g.nt ? g.nt : K / BK;
    unsigned voffA[2], voffB[2];
#pragma unroll
    for (int i = 0; i < 2; ++i) { int R, C; stage_rc(tid * 16 + i * 8192, R, C); const int Rb = Epi::PERM ? ((R & ~31) + perm32(R & 31)) : R;
        voffA[i] = (unsigned)(R * K + C) * 2u; voffB[i] = (unsigned)(Rb * K + C) * 2u; }
    const size_t kstep = (size_t)(BK * 2);
    const size_t hstep = (size_t)HALF * K * 2;
    const size_t tstep = 2 * hstep;
    const unsigned ldsw = (unsigned)wid * 1024u;
    const int aoff = lds_byte(wr * 64 + fr, fq * 8), boff = lds_byte(wc * 32 + fr, fq * 8);
#define PG8_SA(b, h) (((b) * 2 + (h)) * HTB)
#define PG8_SB(b, h) ((4 + (b) * 2 + (h)) * HTB)
#define PG8_STAGE(bufoff, gbase, voff) do { _Pragma("unroll") for (int _i = 0; _i < 2; ++_i) \
        __builtin_amdgcn_global_load_lds((const unsigned*)((const char*)(gbase) + (voff)[_i]), (PG8_LAS unsigned*)(lds + (bufoff) + ldsw + _i * 8192), 16, 0, 0); } while (0)
#define PG8_LDA(dst, b, h) do { _Pragma("unroll") for (int m = 0; m < 4; ++m) _Pragma("unroll") for (int k = 0; k < 2; ++k) dst[m][k] = *(const PG8_LAS bf16x8*)(lds + PG8_SA(b, h) + aoff + m * 2048 + k * 1024); } while (0)
#define PG8_LDB(dst, b, h) do { _Pragma("unroll") for (int n = 0; n < 2; ++n) _Pragma("unroll") for (int k = 0; k < 2; ++k) dst[n][k] = *(const PG8_LAS bf16x8*)(lds + PG8_SB(b, h) + boff + n * 2048 + k * 1024); } while (0)
#define PG8_MMA(ai, bj, At, Bt) do { __builtin_amdgcn_s_setprio(1); _Pragma("unroll") for (int m = 0; m < 4; ++m) _Pragma("unroll") for (int n = 0; n < 2; ++n) _Pragma("unroll") for (int k = 0; k < 2; ++k) \
        acc[ai][bj][m][n] = __builtin_amdgcn_mfma_f32_16x16x32_bf16(Bt[n][k], At[m][k], acc[ai][bj][m][n], 0, 0, 0); __builtin_amdgcn_s_setprio(0); } while (0)
#define PG8_WAIT_V(n) asm volatile("s_waitcnt vmcnt(" #n ")" ::: "memory")
#define PG8_WAIT_L(n) asm volatile("s_waitcnt lgkmcnt(" #n ")" ::: "memory")
#define PG8_BAR __builtin_amdgcn_s_barrier()
#define PG8_SCHED __builtin_amdgcn_sched_barrier(0)
    Unit cur, nxt; int ui = 0;
    if (!S.next(0, cur)) return;
    f32x4 acc[2][2][4][2];
#pragma unroll
    for (int a = 0; a < 2; ++a)
#pragma unroll
        for (int b = 0; b < 2; ++b)
#pragma unroll
            for (int m = 0; m < 4; ++m)
#pragma unroll
                for (int n = 0; n < 2; ++n) acc[a][b][m][n] = (f32x4){0.f, 0.f, 0.f, 0.f};
    bf16x8 At[4][2], B0[2][2], B1[2][2];
    const size_t ko0 = (cur.pn >= g.ksplit) ? (size_t)g.koff * 2 : 0;
    const char* cA = (const char*)g.A + (size_t)cur.pm * tstep + ko0; const char* cB = (const char*)g.Bt + (size_t)cur.pn * tstep + ko0;
    S.a_ready(cur);
    if constexpr (SP2) {
        PG8_STAGE(PG8_SB(0, 0), cB, voffB); PG8_STAGE(PG8_SB(0, 1), cB + hstep, voffB); PG8_STAGE(PG8_SA(0, 0), cA, voffA); PG8_STAGE(PG8_SA(0, 1), cA + hstep, voffA);
        if (wr == 1) PG8_BAR;
        PG8_WAIT_V(2); PG8_BAR;
        PG8_STAGE(PG8_SB(1, 0), cB + kstep, voffB); PG8_STAGE(PG8_SA(1, 0), cA + kstep, voffA); PG8_STAGE(PG8_SB(1, 1), cB + hstep + kstep, voffB);
        PG8_WAIT_V(6); PG8_BAR;
    } else {
        PG8_STAGE(PG8_SB(0, 0), cB, voffB); PG8_STAGE(PG8_SA(0, 0), cA, voffA); PG8_STAGE(PG8_SB(0, 1), cB + hstep, voffB); PG8_STAGE(PG8_SA(0, 1), cA + hstep, voffA);
        if (wr == 1) PG8_BAR;
        PG8_WAIT_V(4); PG8_BAR;
        PG8_STAGE(PG8_SB(1, 0), cB + kstep, voffB); PG8_STAGE(PG8_SA(1, 0), cA + kstep, voffA); PG8_STAGE(PG8_SB(1, 1), cB + hstep + kstep, voffB);
        PG8_WAIT_V(6); PG8_BAR;
    }
    for (;;) {
        const bool has_next = S.next(ui + 1, nxt);
        const size_t ko1 = (has_next && nxt.pn >= g.ksplit) ? (size_t)g.koff * 2 : 0;
        const char* nA = has_next ? (const char*)g.A + (size_t)nxt.pm * tstep + ko1 : cA; const char* nB = has_next ? (const char*)g.Bt + (size_t)nxt.pn * tstep + ko1 : cB;
        for (int t = 0; t < nt; t += 2) {
            const bool last = (t == nt - 2);
            const char* a1 = cA + (size_t)(t + 1) * kstep;
            const char* a2 = last ? nA : cA + (size_t)(t + 2) * kstep; const char* b2 = last ? nB : cB + (size_t)(t + 2) * kstep;
            const char* a3 = a2 + kstep; const char* b3 = b2 + kstep;
            if (last && has_next) S.a_ready(nxt);
            if constexpr (SP2) {
            PG8_LDB(B0, 0, 0); PG8_LDB(B1, 0, 1); PG8_SCHED; PG8_LDA(At, 0, 0); PG8_STAGE(PG8_SA(1, 1), a1 + hstep, voffA);
            PG8_WAIT_V(8); PG8_WAIT_L(0); PG8_BAR; PG8_MMA(0, 0, At, B0); PG8_MMA(0, 1, At, B1); PG8_BAR; PG8_SCHED;
            PG8_LDA(At, 0, 1); PG8_STAGE(PG8_SB(0, 0), b2, voffB); PG8_STAGE(PG8_SB(0, 1), b2 + hstep, voffB); PG8_STAGE(PG8_SA(0, 0), a2, voffA);
            PG8_WAIT_V(8); PG8_WAIT_L(0); PG8_BAR; PG8_MMA(1, 0, At, B0); PG8_MMA(1, 1, At, B1); PG8_BAR; PG8_SCHED;
            PG8_LDB(B0, 1, 0); PG8_LDB(B1, 1, 1); PG8_SCHED; PG8_LDA(At, 1, 0); PG8_STAGE(PG8_SA(0, 1), a2 + hstep, voffA);
            PG8_WAIT_V(8); PG8_WAIT_L(0); PG8_BAR; PG8_MMA(0, 0, At, B0); PG8_MMA(0, 1, At, B1); PG8_BAR; PG8_SCHED;
            PG8_LDA(At, 1, 1); PG8_STAGE(PG8_SB(1, 0), b3, voffB); PG8_STAGE(PG8_SB(1, 1), b3 + hstep, voffB); PG8_STAGE(PG8_SA(1, 0), a3, voffA);
            PG8_WAIT_V(8); PG8_WAIT_L(0); PG8_BAR; PG8_MMA(1, 0, At, B0); PG8_MMA(1, 1, At, B1); PG8_BAR; PG8_SCHED;
            } else {
            PG8_LDB(B0, 0, 0); PG8_SCHED; PG8_LDA(At, 0, 0); PG8_STAGE(PG8_SA(1, 1), a1 + hstep, voffA);
            PG8_WAIT_L(8); PG8_BAR; PG8_WAIT_L(0); PG8_MMA(0, 0, At, B0); PG8_BAR; PG8_SCHED;
            PG8_LDB(B1, 0, 1); PG8_STAGE(PG8_SB(0, 0), b2, voffB);
            PG8_BAR; PG8_WAIT_L(0); PG8_MMA(0, 1, At, B1); PG8_BAR;
            PG8_LDA(At, 0, 1); PG8_STAGE(PG8_SA(0, 0), a2, voffA);
            PG8_BAR; PG8_WAIT_L(0); PG8_MMA(1, 0, At, B0); PG8_BAR; PG8_SCHED;
            PG8_STAGE(PG8_SB(0, 1), b2 + hstep, voffB);
            PG8_WAIT_V(6); PG8_BAR; PG8_MMA(1, 1, At, B1); PG8_BAR;
            PG8_LDB(B0, 1, 0); PG8_SCHED; PG8_LDA(At, 1, 0); PG8_STAGE(PG8_SA(0, 1), a2 + hstep, voffA);
            PG8_WAIT_L(8); PG8_BAR; PG8_WAIT_L(0); PG8_MMA(0, 0, At, B0); PG8_BAR; PG8_SCHED;
            PG8_LDB(B1, 1, 1); PG8_STAGE(PG8_SB(1, 0), b3, voffB);
            PG8_BAR; PG8_WAIT_L(0); PG8_MMA(0, 1, At, B1); PG8_BAR;
            PG8_LDA(At, 1, 1); PG8_STAGE(PG8_SA(1, 0), a3, voffA);
            PG8_BAR; PG8_WAIT_L(0); PG8_MMA(1, 0, At, B0); PG8_BAR; PG8_SCHED;
            PG8_STAGE(PG8_SB(1, 1), b3 + hstep, voffB);
            PG8_WAIT_V(6); PG8_BAR; PG8_MMA(1, 1, At, B1); PG8_BAR;
            }
        }
        if constexpr (ALIGN_EPI) { if (wr == 0) PG8_BAR; }
        if constexpr (!Epi::AFTER_DRAIN) { E(acc, cur, wr, wc, fr, fq); S.done(cur); }
        if (!has_next) break;
        PG8_WAIT_V(0);
#pragma unroll
        for (int a = 0; a < 2; ++a)
#pragma unroll
            for (int b = 0; b < 2; ++b)
#pragma unroll
                for (int m = 0; m < 4; ++m)
#pragma unroll
                    for (int n = 0; n < 2; ++n) acc[a][b][m][n] = (f32x4){0.f, 0.f, 0.f, 0.f};
        cur = nxt; cA = nA; cB = nB; ++ui;
        if constexpr (ALIGN_EPI) { if (wr == 1) PG8_BAR; }
    }
    PG8_WAIT_V(0);
    if constexpr (!ALIGN_EPI) { if (wr == 0) PG8_BAR; }
    PG8_BAR;
    if constexpr (Epi::AFTER_DRAIN) { E.fused(acc, cur, wr, wc, fr, fq, lds, wid, lane); S.done(cur); }
#undef PG8_SA
#undef PG8_SB
#undef PG8_STAGE
#undef PG8_LDA
#undef PG8_LDB
#undef PG8_MMA
#undef PG8_WAIT_V
#undef PG8_WAIT_L
#undef PG8_BAR
#undef PG8_SCHED
}
}
#define LAS __attribute__((address_space(3)))
typedef unsigned short bf16;
typedef float f32x4 __attribute__((ext_vector_type(4)));
typedef float f32x2v __attribute__((ext_vector_type(2)));
typedef unsigned u32x4v __attribute__((ext_vector_type(4)));
typedef unsigned u32x2v __attribute__((ext_vector_type(2)));
typedef short bf16x8 __attribute__((ext_vector_type(8)));

constexpr int NB = 2, T = 4096, M = NB * T, D = 2048, L = 4;
constexpr int MIXA = 512, MIXB = 1024, MIXC = 512, NIN = 6080, NP = 6144, FF = 8192;
constexpr int RW0 = 1024;
constexpr int PC0 = 1024 + 3520;
constexpr int NLORA = 3072, KLORA = 512;
constexpr int NPH = 11;
constexpr int NWAVES = 8;
constexpr int LDS_BYTES = 147456;
constexpr float RMS_EPS = 1e-6f, LNX_EPS = 64e-5f;

constexpr size_t MiB = 1u << 20;
constexpr size_t WS_WIN = 0;
constexpr size_t WS_WOUT = WS_WIN + 96 * MiB;
constexpr size_t WS_WUP = WS_WOUT + 32 * MiB;
constexpr size_t WS_WDN = WS_WUP + 128 * MiB;
constexpr size_t WS_WLORA = WS_WDN + 128 * MiB;
constexpr size_t WS_XB = WS_WLORA + 12 * MiB;
constexpr size_t WS_Y = WS_XB + 32 * MiB;
constexpr size_t WS_MIX = WS_Y + 64 * MiB;
constexpr size_t WS_P = WS_MIX + 32 * MiB;
constexpr size_t WS_ALORA = WS_P + 96 * MiB;
constexpr size_t WS_LORA = WS_ALORA + 8 * MiB;
constexpr size_t WS_SCANIN = WS_LORA + 96 * MiB;
constexpr size_t WS_U = WS_SCANIN;
constexpr size_t WS_SV = WS_SCANIN + 160 * MiB;
constexpr size_t WS_SC = WS_SV + 32 * MiB;
constexpr size_t WS_SB = WS_SC + 3 * MiB;
constexpr size_t WS_YS = WS_SB + 1 * MiB;
constexpr size_t WS_CTL = WS_YS + 32 * MiB;
constexpr size_t CTL_BYTES = 65536;
constexpr size_t WS_XR = WS_CTL + 1 * MiB;
constexpr size_t WS_END = WS_XR + 32 * MiB;
constexpr int LDS_BAR_OFF = LDS_BYTES - 16;

struct Params { const float* in[26]; float* out; unsigned char* ws; int ph_lo, ph_hi; };
enum { I_X = 0, I_NMIXPRE, I_NMIXPOST, I_NMLPPRE, I_NMLPPOST, I_WIN, I_GMVG, I_GMWS, I_GMBS, I_GMOG, I_MU, I_W0, I_WUP, I_A0, I_AUP, I_GUP,
       I_KK, I_KA, I_RK, I_LNW, I_LNB, I_CONV, I_SCOG, I_WOUT, I_MUP, I_MDN };

__device__ __forceinline__ float bf2f(bf16 b) { return __builtin_bit_cast(float, ((unsigned)b) << 16); }
__device__ __forceinline__ unsigned f2bf(float f) { unsigned u = __builtin_bit_cast(unsigned, f); return (u + 0x7fffu + ((u >> 16) & 1u)) >> 16; }
__device__ __forceinline__ unsigned pk2(float lo, float hi) { unsigned r; asm volatile("v_cvt_pk_bf16_f32 %0, %1, %2" : "=v"(r) : "v"(lo), "v"(hi)); return r; }
__device__ __forceinline__ float lo16(unsigned u) { return __builtin_bit_cast(float, u << 16); }
__device__ __forceinline__ float hi16(unsigned u) { return __builtin_bit_cast(float, u & 0xffff0000u); }
template <int CTRL> __device__ __forceinline__ float dppf(float v) {
    return __builtin_bit_cast(float, __builtin_amdgcn_update_dpp(0, __builtin_bit_cast(int, v), CTRL, 0xF, 0xF, true));
}
__device__ __forceinline__ float row16_sum(float v) {
    v += dppf<0xB1>(v); v += dppf<0x4E>(v); v += dppf<0x124>(v); v += dppf<0x128>(v);
    return v;
}
__device__ __forceinline__ float wave_sum(float v) {
    v = row16_sum(v);
    const int iv = __builtin_bit_cast(int, v);
    const float a = __builtin_bit_cast(float, __builtin_amdgcn_readlane(iv, 0)), b = __builtin_bit_cast(float, __builtin_amdgcn_readlane(iv, 16));
    const float c = __builtin_bit_cast(float, __builtin_amdgcn_readlane(iv, 32)), d = __builtin_bit_cast(float, __builtin_amdgcn_readlane(iv, 48));
    return (a + b) + (c + d);
}
__device__ __forceinline__ float sigmoidf_(float x) { return 1.f / (1.f + __expf(-x)); }
__device__ __forceinline__ float gelu_tanh(float x) {
    const float u = 1.5957691216057308f * (x + 0.044715f * x * x * x);
    return x * __builtin_amdgcn_rcpf(1.f + __expf(-u));
}

struct TrItem { const float* W; bf16* WT; int K, N, k0, n0; };
__device__ __forceinline__ void tr_load(const TrItem& t, f32x4 (&v)[16], int lane) {
    const int lr = lane >> 4, lc = (lane & 15) * 4;
#pragma unroll
    for (int i = 0; i < 16; ++i) v[i] = *(const f32x4*)(t.W + (size_t)(t.k0 + 4 * i + lr) * t.N + t.n0 + lc);
}
__device__ __forceinline__ void tr_store(const TrItem& t, const f32x4 (&v)[16], LAS float* scr, int lane) {
    const int lr = lane >> 4, lc = (lane & 15) * 4;
#pragma unroll
    for (int i = 0; i < 16; ++i) { LAS float* s = scr + (4 * i + lr) * 65 + lc; s[0] = v[i][0]; s[1] = v[i][1]; s[2] = v[i][2]; s[3] = v[i][3]; }
    asm volatile("s_waitcnt lgkmcnt(0)" ::: "memory");
    const int c = lane & 7;
#pragma unroll
    for (int j = 0; j < 8; ++j) { const int n = (lane >> 3) + 8 * j; const LAS float* s = scr + (8 * c) * 65 + n;
        u32x4v o; o.x = pk2(s[0 * 65], s[1 * 65]); o.y = pk2(s[2 * 65], s[3 * 65]); o.z = pk2(s[4 * 65], s[5 * 65]); o.w = pk2(s[6 * 65], s[7 * 65]);
        *(u32x4v*)(t.WT + (size_t)(t.n0 + n) * t.K + t.k0 + 8 * c) = o; }
    asm volatile("s_waitcnt lgkmcnt(0)" ::: "memory");
}

constexpr int TR_I_IN = (D / 64) * (NIN / 64), TR_I_O = (D / 64) * (D / 64), TR_I_U = (D / 64) * (FF / 64), TR_I_D = (FF / 64) * (D / 64);
constexpr int TR_PER_L = TR_I_IN + TR_I_O + TR_I_U + TR_I_D;
__device__ __forceinline__ TrItem tr_decode(const Params& P, int it) {
    unsigned char* ws = P.ws;
    const int l = it / TR_PER_L; int r = it % TR_PER_L; TrItem t;
    if (r < TR_I_IN) { t.W = P.in[I_WIN] + (size_t)l * D * NIN; t.WT = (bf16*)(ws + WS_WIN) + (size_t)l * NP * D; t.K = D; t.N = NIN; t.k0 = 64 * (r / (NIN / 64)); t.n0 = 64 * (r % (NIN / 64)); }
    else if ((r -= TR_I_IN) < TR_I_O) { t.W = P.in[I_WOUT] + (size_t)l * D * D; t.WT = (bf16*)(ws + WS_WOUT) + (size_t)l * D * D; t.K = D; t.N = D; t.k0 = 64 * (r / (D / 64)); t.n0 = 64 * (r % (D / 64)); }
    else if ((r -= TR_I_O) < TR_I_U) { t.W = P.in[I_MUP] + (size_t)l * D * FF; t.WT = (bf16*)(ws + WS_WUP) + (size_t)l * FF * D; t.K = D; t.N = FF; t.k0 = 64 * (r / (FF / 64)); t.n0 = 64 * (r % (FF / 64)); }
    else { r -= TR_I_U; t.W = P.in[I_MDN] + (size_t)l * FF * D; t.WT = (bf16*)(ws + WS_WDN) + (size_t)l * D * FF; t.K = FF; t.N = D; t.k0 = 64 * (r / (D / 64)); t.n0 = 64 * (r % (D / 64)); }
    return t;
}
__device__ __forceinline__ void tr_slab_load(const TrItem& t, f32x4 (&v)[4], int lane) {
    const int lr = lane >> 4, lc = (lane & 15) * 4;
#pragma unroll
    for (int i = 0; i < 4; ++i) v[i] = *(const f32x4*)(t.W + (size_t)(t.k0 + 4 * i + lr) * t.N + t.n0 + lc);
}
__device__ __forceinline__ void tr_slab_store(const TrItem& t, const f32x4 (&v)[4], LAS float* scr, int lane) {
    const int lr = lane >> 4, lc = (lane & 15) * 4;
#pragma unroll
    for (int i = 0; i < 4; ++i) *(LAS f32x4*)(scr + (4 * i + lr) * 68 + lc) = v[i];
    asm volatile("s_waitcnt lgkmcnt(0)" ::: "memory");
    const LAS float* s = scr + lane;
    u32x4v o0, o1;
    o0.x = pk2(s[0 * 68], s[1 * 68]); o0.y = pk2(s[2 * 68], s[3 * 68]); o0.z = pk2(s[4 * 68], s[5 * 68]); o0.w = pk2(s[6 * 68], s[7 * 68]);
    o1.x = pk2(s[8 * 68], s[9 * 68]); o1.y = pk2(s[10 * 68], s[11 * 68]); o1.z = pk2(s[12 * 68], s[13 * 68]); o1.w = pk2(s[14 * 68], s[15 * 68]);
    bf16* dst = t.WT + (size_t)(t.n0 + lane) * t.K + t.k0;
    *(u32x4v*)dst = o0; *(u32x4v*)(dst + 8) = o1;
    asm volatile("s_waitcnt lgkmcnt(0)" ::: "memory");
}

__device__ __forceinline__ void rms_row_to_bf16(const float* xrow, const float* gain, bf16* orow, int lane) {
    f32x4 v[8]; float s = 0.f;
#pragma unroll
    for (int j = 0; j < 8; ++j) { v[j] = ((const f32x4*)xrow)[lane + 64 * j]; s += (v[j][0] * v[j][0] + v[j][1] * v[j][1]) + (v[j][2] * v[j][2] + v[j][3] * v[j][3]); }
    const float inv = rsqrtf(wave_sum(s) * (1.f / D) + RMS_EPS);
#pragma unroll
    for (int j = 0; j < 8; ++j) { const f32x4 g = ((const f32x4*)gain)[lane + 64 * j];
        u32x2v o; o.x = pk2(v[j][0] * inv * g[0], v[j][1] * inv * g[1]); o.y = pk2(v[j][2] * inv * g[2], v[j][3] * inv * g[3]);
        ((u32x2v*)orow)[lane + 64 * j] = o; }
}

__device__ __forceinline__ void phase0(const Params& P, LAS unsigned char* lds, int wave, int lane) {
    unsigned char* ws = P.ws;
    LAS float* scr = (LAS float*)(lds + wave * 16640);
    const int gw = blockIdx.x * NWAVES + wave, NGW = gridDim.x * NWAVES;
    const int n_items = ((int)gridDim.x * 4 * (T / 32) >= 4 * TR_PER_L) ? TR_PER_L : L * TR_PER_L;
    if (gw < n_items) {
        TrItem cur = tr_decode(P, gw); f32x4 va[16]; tr_load(cur, va, lane);
        for (int it = gw; it < n_items; it += NGW) {
            const bool more = (it + NGW < n_items);
            const TrItem nxt = tr_decode(P, more ? it + NGW : it);
            f32x4 vb[16]; tr_load(nxt, vb, lane);
            tr_store(cur, va, scr, lane);
            cur = nxt;
#pragma unroll
            for (int i = 0; i < 16; ++i) va[i] = vb[i];
        }
    }
    const int gt = blockIdx.x * 512 + threadIdx.x, NGT = gridDim.x * 512;
    for (int i = gt; i < L * (NP - NIN) * D / 8; i += NGT) { const int l = i / ((NP - NIN) * D / 8), r = i % ((NP - NIN) * D / 8);
        ((u32x4v*)((bf16*)(ws + WS_WIN) + (size_t)l * NP * D + (size_t)NIN * D))[r] = (u32x4v){0u, 0u, 0u, 0u}; }
    for (int i = gt; i < L * NLORA * KLORA; i += NGT) {
        const int l = i / (NLORA * KLORA), r = i % (NLORA * KLORA), n = r / KLORA, k = r % KLORA; float v = 0.f;
        if (n < 1024) { if (k < 96) v = P.in[I_WUP][((size_t)l * 96 + k) * 1024 + n]; }
        else if (n < 2048) { if (k >= 96 && k < 192) v = P.in[I_AUP][((size_t)l * 96 + (k - 96)) * 1024 + (n - 1024)]; }
        else { if (k >= 192 && k < 448) v = P.in[I_GUP][((size_t)l * 256 + (k - 192)) * 1024 + (n - 2048)]; }
        ((bf16*)(ws + WS_WLORA))[i] = (bf16)f2bf(v);
    }
    for (int m = gw; m < M; m += NGW) rms_row_to_bf16(P.in[I_X] + (size_t)m * D, P.in[I_NMIXPRE], (bf16*)(ws + WS_XB) + (size_t)m * D, lane);
}

__device__ __forceinline__ void gmlp_unit(const Params& P, int l, int unit, LAS unsigned char* lds, int wave, int lane) {
    const int g = unit & 3, bc = unit >> 2; const int m0 = bc * 128;
    const bf16* Pp = (const bf16*)(P.ws + WS_P);
    bf16* MIX = (bf16*)(P.ws + WS_MIX);
    constexpr int VS = 136;
    LAS bf16* vT = (LAS bf16*)lds;
    const float* vg = P.in[I_GMVG] + l * MIXA + g * 128;
    const int fr = lane & 15, fq = lane >> 4, t0 = wave * 16;
    const float* Wg = P.in[I_GMWS] + ((size_t)(l * 4 + g) * 128) * 128;
    f32x4 wpre[4][2];
#pragma unroll
    for (int kk = 0; kk < 4; ++kk) { const int kq = (32 * kk <= t0 + 15) ? kk : 0; const float* wp = Wg + (t0 + fr) * 128 + 32 * kq + fq * 8;
        wpre[kk][0] = *(const f32x4*)wp; wpre[kk][1] = *(const f32x4*)(wp + 4); }
    {
        const float g0 = vg[2 * lane], g1 = vg[2 * lane + 1];
        unsigned pvv[16];
#pragma unroll
        for (int i = 0; i < 16; ++i) pvv[i] = *(const unsigned*)(Pp + (size_t)(m0 + wave * 16 + i) * NP + 512 + g * 128 + 2 * lane);
#pragma unroll
        for (int i = 0; i < 16; ++i) { const int s = wave * 16 + i;
            const unsigned pv = pvv[i];
            const float z0 = gelu_tanh(lo16(pv)), z1 = gelu_tanh(hi16(pv));
            const float inv = rsqrtf(wave_sum(z0 * z0 + z1 * z1) * (1.f / 128.f) + RMS_EPS);
            vT[(2 * lane) * VS + s] = (bf16)f2bf(z0 * inv * g0); vT[(2 * lane + 1) * VS + s] = (bf16)f2bf(z1 * inv * g1); }
    }
    __syncthreads();
    bf16 uraw[4][8];
#pragma unroll
    for (int j = 0; j < 4; ++j)
#pragma unroll
        for (int n = 0; n < 8; ++n) uraw[j][n] = Pp[(size_t)(m0 + t0 + 4 * fq + j) * NP + g * 128 + n * 16 + fr];
    f32x4 acc[8];
#pragma unroll
    for (int n = 0; n < 8; ++n) acc[n] = (f32x4){0.f, 0.f, 0.f, 0.f};
#pragma unroll
    for (int kk = 0; kk < 4; ++kk) {
        if (32 * kk > t0 + 15) continue;
        const int trow = t0 + fr, k0 = 32 * kk + fq * 8;
        const f32x4 w0 = wpre[kk][0], w1 = wpre[kk][1];
        float wv[8] = {w0[0], w0[1], w0[2], w0[3], w1[0], w1[1], w1[2], w1[3]};
        bf16x8 a;
#pragma unroll
        for (int j = 0; j < 8; ++j) a[j] = (short)f2bf((k0 + j <= trow) ? wv[j] : 0.f);
#pragma unroll
        for (int n = 0; n < 8; ++n) { const bf16x8 b = *(const LAS bf16x8*)(vT + (n * 16 + fr) * VS + k0);
            acc[n] = __builtin_amdgcn_mfma_f32_16x16x32_bf16(a, b, acc[n], 0, 0, 0); }
    }
    const float* bsg = P.in[I_GMBS] + (l * 4 + g) * 128;
    const float* og = P.in[I_GMOG] + l * MIXA + g * 128;
    float ss[4] = {0.f, 0.f, 0.f, 0.f};
#pragma unroll
    for (int j = 0; j < 4; ++j) { const int t = t0 + 4 * fq + j; const float bias = bsg[t];
#pragma unroll
        for (int n = 0; n < 8; ++n) { const float u = gelu_tanh(bf2f(uraw[j][n]));
            const float o = u * (acc[n][j] + bias); acc[n][j] = o; ss[j] += o * o; } }
#pragma unroll
    for (int j = 0; j < 4; ++j) { float s = ss[j]; s += dppf<0xB1>(s); s += dppf<0x4E>(s); s += dppf<0x124>(s); s += dppf<0x128>(s); ss[j] = rsqrtf(s * (1.f / 128.f) + RMS_EPS); }
#pragma unroll
    for (int n = 0; n < 8; ++n) { const float gn = og[n * 16 + fr];
#pragma unroll
        for (int j = 0; j < 4; ++j) { const int t = t0 + 4 * fq + j; MIX[(size_t)(m0 + t) * D + g * 128 + n * 16 + fr] = (bf16)f2bf(acc[n][j] * ss[j] * gn); } }
    __syncthreads();
}

__device__ __forceinline__ void unpack8(const u32x4v u, float (&f)[8]) {
    f[0] = lo16(u.x); f[1] = hi16(u.x); f[2] = lo16(u.y); f[3] = hi16(u.y); f[4] = lo16(u.z); f[5] = hi16(u.z); f[6] = lo16(u.w); f[7] = hi16(u.w);
}

__device__ __forceinline__ void phase_e1(const Params& P, int l, LAS unsigned char* lds, int wave, int lane) {
    for (int unit = blockIdx.x; unit < 256; unit += gridDim.x) gmlp_unit(P, l, unit, lds, wave, lane);
    const int gw = blockIdx.x * NWAVES + wave, NGW = gridDim.x * NWAVES;
    const bf16* Pp = (const bf16*)(P.ws + WS_P);
    bf16* MIX = (bf16*)(P.ws + WS_MIX);
    bf16* AL = (bf16*)(P.ws + WS_ALORA);
    {
        const float* cw = P.in[I_CONV] + (size_t)l * 3 * MIXC; const float* sg = P.in[I_SCOG] + l * MIXC;
        float w0[8], w1[8], w2[8], gn[8];
#pragma unroll
        for (int e = 0; e < 8; ++e) { w0[e] = cw[8 * lane + e]; w1[e] = cw[MIXC + 8 * lane + e]; w2[e] = cw[2 * MIXC + 8 * lane + e]; gn[e] = sg[8 * lane + e]; }
        for (int mb = gw; mb < M; mb += 2 * NGW) {
            u32x4v raw[2][7];
#pragma unroll
            for (int q = 0; q < 2; ++q) { const int m = (mb + q * NGW < M) ? mb + q * NGW : mb; const int t = m & (T - 1);
                const bf16* pr = Pp + (size_t)m * NP + PC0 + 8 * lane;
                const bf16* p1 = (t >= 1) ? pr - NP : pr; const bf16* p2 = (t >= 2) ? pr - 2 * NP : pr;
                raw[q][0] = *(const u32x4v*)pr; raw[q][1] = *(const u32x4v*)(pr + 512); raw[q][2] = *(const u32x4v*)(pr + 1024);
                raw[q][3] = *(const u32x4v*)(p1 + 512); raw[q][4] = *(const u32x4v*)(p1 + 1024); raw[q][5] = *(const u32x4v*)(p2 + 512); raw[q][6] = *(const u32x4v*)(p2 + 1024); }
#pragma unroll
            for (int q = 0; q < 2; ++q) { const int m = mb + q * NGW; if (m >= M) break; const int t = m & (T - 1);
                float gb[8], c0[8], h0[8], c1[8], h1[8], c2[8], h2[8];
                unpack8(raw[q][0], gb); unpack8(raw[q][1], c0); unpack8(raw[q][2], h0); unpack8(raw[q][3], c1); unpack8(raw[q][4], h1); unpack8(raw[q][5], c2); unpack8(raw[q][6], h2);
                const float k1 = (t >= 1) ? 1.f : 0.f, k2 = (t >= 2) ? 1.f : 0.f;
                float y[8], s = 0.f;
#pragma unroll
                for (int e = 0; e < 8; ++e) { y[e] = gb[e] * (w0[e] * k2 * (c2[e] * h2[e]) + w1[e] * k1 * (c1[e] * h1[e]) + w2[e] * (c0[e] * h0[e])); s += y[e] * y[e]; }
                s += dppf<0xB1>(s); s += dppf<0x4E>(s); s += dppf<0x141>(s);
                const float inv = rsqrtf(s * (1.f / 64.f) + RMS_EPS);
                u32x4v o; o.x = pk2(y[0] * inv * gn[0], y[1] * inv * gn[1]); o.y = pk2(y[2] * inv * gn[2], y[3] * inv * gn[3]);
                o.z = pk2(y[4] * inv * gn[4], y[5] * inv * gn[5]); o.w = pk2(y[6] * inv * gn[6], y[7] * inv * gn[7]);
                *(u32x4v*)(MIX + (size_t)m * D + 1536 + 8 * lane) = o; }
        }
    }
    {
        const float* mu = P.in[I_MU] + (size_t)l * 3520 + 3072;
        const int q0 = 8 * lane; float muv[8];
#pragma unroll
        for (int e = 0; e < 8; ++e) muv[e] = (q0 < 448) ? mu[q0 + e] : 0.f;
        for (int mb = gw; mb < M; mb += 4 * NGW) {
            u32x4v rc[4], rp[4];
#pragma unroll
            for (int q = 0; q < 4; ++q) { const int m = (mb + q * NGW < M) ? mb + q * NGW : mb; const int t = m & (T - 1);
                const bf16* pr = Pp + (size_t)m * NP + RW0 + 3072 + ((q0 < 448) ? q0 : 0);
                rc[q] = *(const u32x4v*)pr; rp[q] = *(const u32x4v*)((t >= 1) ? pr - NP : pr); }
#pragma unroll
            for (int q = 0; q < 4; ++q) { const int m = mb + q * NGW; if (m >= M) break; const int t = m & (T - 1);
                u32x4v o = (u32x4v){0u, 0u, 0u, 0u};
                if (q0 < 448) { float c[8], pv[8], f[8];
                    unpack8(rc[q], c); unpack8(rp[q], pv);
                    const float k1 = (t >= 1) ? 1.f : 0.f;
#pragma unroll
                    for (int e = 0; e < 8; ++e) { const float x = c[e] + (pv[e] * k1 - c[e]) * muv[e];
                        f[e] = (q0 < 96) ? tanhf(x) : ((q0 < 192) ? x : sigmoidf_(x)); }
                    o.x = pk2(f[0], f[1]); o.y = pk2(f[2], f[3]); o.z = pk2(f[4], f[5]); o.w = pk2(f[6], f[7]); }
                *(u32x4v*)(AL + (size_t)m * KLORA + q0) = o; }
        }
    }
}

__device__ __forceinline__ float swap16_sum(float v) {
    float a = v, b = v;
    asm volatile("s_nop 1\n\tv_permlane16_swap_b32 %0, %1" : "+v"(a), "+v"(b));
    return a + b;
}
__device__ __forceinline__ float swap32_sum(float v) {
    float a = v, b = v;
    asm volatile("s_nop 1\n\tv_permlane32_swap_b32 %0, %1" : "+v"(a), "+v"(b));
    return a + b;
}
struct E2Tok { float r, v, decay, a, kkr, kmod; };
struct E2Raw { float r0, k0, v0, wl, al; };
__device__ __forceinline__ E2Raw e2_load(const bf16* Pp, const bf16* LO, int m, int c) {
    const bf16* pr = Pp + (size_t)m * NP + RW0; const bf16* lo = LO + (size_t)m * NLORA;
    E2Raw w; w.r0 = bf2f(pr[c]); w.k0 = bf2f(pr[1024 + c]); w.v0 = bf2f(pr[2048 + c]); w.wl = bf2f(lo[c]); w.al = bf2f(lo[1024 + c]); return w;
}
__device__ __forceinline__ E2Tok e2_token(const E2Raw& w, float& r1, float& k1, float& v1, float mur, float muk, float muv, float w0c, float a0c, float kkc, float kac) {
    const float r0 = w.r0, k0 = w.k0, v0 = w.v0, wl = w.wl, al = w.al;
    E2Tok o;
    o.r = r0 + (r1 - r0) * mur; const float k = k0 + (k1 - k0) * muk; o.v = v0 + (v1 - v0) * muv;
    r1 = r0; k1 = k0; v1 = v0;
    const float z = -(w0c + wl);
    const float sp = fmaxf(z, 0.f) + __logf(1.f + __expf(-fabsf(z)));
    o.decay = __expf(-__expf(-sp - 0.5f));
    o.a = __builtin_amdgcn_rcpf(1.f + __expf(-(a0c + al)));
    o.kkr = k * kkc;
    o.kmod = k * (1.f + (o.a - 1.f) * kac);
    return o;
}
__device__ __forceinline__ float sum4(float q0, float q1, float q2, float q3, bool o1, bool o2) {
    const float u01 = (o1 ? q1 : q0) + dppf<0xB1>(o1 ? q0 : q1);
    const float u23 = (o1 ? q3 : q2) + dppf<0xB1>(o1 ? q2 : q3);
    float u = (o2 ? u23 : u01) + dppf<0x4E>(o2 ? u01 : u23);
    u += dppf<0x124>(u); u += dppf<0x128>(u);
    u = swap16_sum(u); u = swap32_sum(u);
    return u;
}
__device__ __forceinline__ void phase_e2(const Params& P, int l, int wave, int lane) {
    const int gw = blockIdx.x * NWAVES + wave, NGW = gridDim.x * NWAVES;
    const bf16* Pp = (const bf16*)(P.ws + WS_P);
    const bf16* LO = (const bf16*)(P.ws + WS_LORA);
    float* SI = (float*)(P.ws + WS_SCANIN); float* SV = (float*)(P.ws + WS_SV); float* SC = (float*)(P.ws + WS_SC); float* SB = (float*)(P.ws + WS_SB);
    const float* mu = P.in[I_MU] + (size_t)l * 3520;
    const bool o1 = (lane & 1) != 0, o2 = (lane & 2) != 0;
    for (int wt = gw; wt < (M / 64) * 16; wt += NGW) {
        const int h = wt & 15, m0 = (wt >> 4) * 64, c = h * 64 + lane, b = m0 >> 12;
        const float mur = mu[c], muk = mu[1024 + c], muv = mu[2048 + c];
        const float w0c = P.in[I_W0][l * MIXB + c], a0c = P.in[I_A0][l * MIXB + c], kkc = P.in[I_KK][l * MIXB + c], kac = P.in[I_KA][l * MIXB + c], rkc = P.in[I_RK][l * MIXB + c];
        float r1 = 0.f, k1 = 0.f, v1 = 0.f;
        if ((m0 & (T - 1)) != 0) { const bf16* pp = Pp + (size_t)(m0 - 1) * NP + RW0; r1 = bf2f(pp[c]); k1 = bf2f(pp[1024 + c]); v1 = bf2f(pp[2048 + c]); }
        const size_t row0 = (size_t)(b * 16 + h) * T + (m0 & (T - 1));
        E2Raw pa0 = e2_load(Pp, LO, m0, c), pa1 = e2_load(Pp, LO, m0 + 1, c), pb0 = e2_load(Pp, LO, m0 + 2, c), pb1 = e2_load(Pp, LO, m0 + 3, c);
        for (int i = 0; i < 64; i += 2) {
            const int m = m0 + i;
            const int mn = (i + 4 < 64) ? m + 4 : m;
            const E2Raw pc0 = e2_load(Pp, LO, mn, c), pc1 = e2_load(Pp, LO, mn + 1, c);
            const E2Tok A = e2_token(pa0, r1, k1, v1, mur, muk, muv, w0c, a0c, kkc, kac);
            const E2Tok B = e2_token(pa1, r1, k1, v1, mur, muk, muv, w0c, a0c, kkc, kac);
            pa0 = pb0; pa1 = pb1; pb0 = pc0; pb1 = pc1;
            const float ka1 = A.kkr * A.a, ka2 = B.kkr * B.a, w2r2 = B.decay * B.r;
            const float uA = sum4(A.kkr * A.kkr, B.kkr * B.kkr, A.r * A.kmod * rkc, B.r * B.kmod * rkc, o1, o2);
            const float uB = sum4(ka1 * B.kkr, ka1 * A.r, ka1 * w2r2, ka2 * B.r, o1, o2);
            const float uC = sum4(A.kmod * B.kkr, A.kmod * A.r, A.kmod * w2r2, B.kmod * B.r, o1, o2);
            const float in1 = 1.f / fmaxf(sqrtf(dppf<0x00>(uA)), 1e-12f), in2 = 1.f / fmaxf(sqrtf(dppf<0x55>(uA)), 1e-12f);
            const float kk1 = A.kkr * in1, kk2 = B.kkr * in2, bs1 = kk1 * A.a, bs2 = kk2 * B.a, w12 = A.decay * B.decay;
            float* o = SI + ((row0 + i) >> 1) * 576;
            o[lane] = -kk1; o[64 + lane] = -(A.decay * kk2); o[128 + lane] = A.decay * A.r; o[192 + lane] = w12 * B.r; o[256 + lane] = w12;
            o[320 + lane] = bs1 * B.decay; o[384 + lane] = A.kmod * B.decay; o[448 + lane] = bs2; o[512 + lane] = B.kmod;
            SV[(row0 + i) * 64 + lane] = A.v; SV[(row0 + i + 1) * 64 + lane] = B.v;
            if (lane < 4) {
                const float sB = (lane == 0) ? -(in1 * in2) : ((lane == 3) ? in2 : in1);
                const float sC = (lane == 0) ? -in2 : 1.f;
                float* sc = SC + ((row0 + i) >> 1) * 12;
                const int ib = (lane == 0) ? 0 : ((lane == 1) ? 4 : ((lane == 2) ? 8 : 10));
                sc[ib] = uB * sB; sc[ib + 1] = uC * sC;
                if (lane < 2) { sc[2 + 4 * lane] = 0.f; sc[3 + 4 * lane] = 0.f; }
                if (lane >= 2) SB[(m + lane - 2) * 16 + h] = uA;
            }
        }
    }
}

constexpr int SCH = 32;
constexpr int SVOFF = (SCH / 2) * 576, SCOFF = SVOFF + SCH * 8;
constexpr int SBUF_F = SCOFF + (SCH / 2) * 12;
struct ScanRegs { f32x4 r[9]; f32x4 e; };
__device__ __forceinline__ void scan_issue(ScanRegs& R, const float* gvec, const float* gv, const float* gsc, int c, int lt) {
    const char* src = (const char*)(gvec + (size_t)c * (SCH / 2) * 576);
    const unsigned loff = (unsigned)lt * 16u;
#pragma unroll
    for (int i = 0; i < 9; ++i) R.r[i] = *(const f32x4*)(src + (size_t)i * 4096 + loff);
    R.e = (f32x4){0.f, 0.f, 0.f, 0.f};
    if (lt < 64) { const int tt = lt >> 1, part = lt & 1; R.e = *(const f32x4*)(gv + (size_t)(c * SCH + tt) * 64 + part * 4); }
    else if (lt < 112) { R.e = ((const f32x4*)(gsc + (size_t)c * (SCH / 2) * 12))[lt - 64]; }
}
__device__ __forceinline__ void scan_commit(const ScanRegs& R, LAS float* buf, int lt) {
#pragma unroll
    for (int i = 0; i < 9; ++i) ((LAS f32x4*)buf)[lt + 256 * i] = R.r[i];
    if (lt < 112) ((LAS f32x4*)(buf + SVOFF))[lt] = R.e;
}
constexpr int YST_OFF_B = 2 * SBUF_F * 4 + 4 * 4352;
static_assert(YST_OFF_B % 16 == 0 && YST_OFF_B + 2048 <= LDS_BAR_OFF, "scan LDS map");
__device__ __forceinline__ void scan_flush_y(LAS const float* ys, float* dst, int lane) {
    const int t = lane >> 1, hh = lane & 1;
    *(f32x4*)(dst + (size_t)t * MIXB + hh * 4) = *(LAS const f32x4*)(ys + t * 8 + hh * 4);
}
__device__ __forceinline__ void phase_scan(const Params& P, int l, LAS unsigned char* lds, int wave, int lane) {
    const float* SI = (const float*)(P.ws + WS_SCANIN); const float* SV = (const float*)(P.ws + WS_SV); const float* SC = (const float*)(P.ws + WS_SC);
    float* YS = (float*)(P.ws + WS_YS);
    const int tid = threadIdx.x;
#ifndef SCAN_ODD_LOADERS
#define SCAN_ODD_LOADERS 0
#endif
    const bool is_loader = SCAN_ODD_LOADERS ? ((wave & 1) != 0) : (wave >= 4);
    const int widx = SCAN_ODD_LOADERS ? (wave >> 1) : (wave & 3), lt = widx * 64 + lane;
    for (int task = blockIdx.x; task < 256; task += gridDim.x) {
        const int x = task & 7, s = task >> 3, bh = x * 4 + (s >> 3), q = s & 7, b = bh >> 4, h = bh & 15;
        const float* gvec = SI + (size_t)bh * (T / 2) * 576;
        const float* gv = SV + (size_t)bh * T * 64 + q * 8;
        const float* gsc = SC + (size_t)bh * (T / 2) * 12;
        LAS float* buf0 = (LAS float*)lds; LAS float* buf1 = buf0 + SBUF_F;
        ScanRegs R;
        const int lw = blockIdx.x * 4 + widx, nslab = (l + 1 < L && task < (int)gridDim.x && (int)gridDim.x * 4 * (T / SCH) >= 4 * TR_PER_L) ? 4 * TR_PER_L : 0;
        LAS float* scrw = (LAS float*)(lds + 2 * SBUF_F * 4) + widx * 1088;
        TrItem sl; f32x4 sv[4]; bool have = false;
        if (is_loader) { scan_issue(R, gvec, gv, gsc, 0, lt); scan_commit(R, buf0, lt); scan_issue(R, gvec, gv, gsc, 1, lt);
            if (lw < nslab) { sl = tr_decode(P, (l + 1) * TR_PER_L + (lw >> 2)); sl.k0 += 16 * (lw & 3); tr_slab_load(sl, sv, lane); have = true; } }
        __syncthreads();
        const int cl = lane & 31, il = widx * 2 + (lane >> 5), g8 = cl >> 2, cls = cl & 3; const bool o1 = (cl & 1) != 0, o2 = (cl & 2) != 0;
        float S0 = 0.f, S1 = 0.f, yrec = 0.f;
        const int ycoef = o1 ? 8 : 4;
        float* ybase = YS + (size_t)(b * T) * MIXB + h * 64 + q * 8;
        for (int c = 0; c < T / SCH; ++c) {
            LAS const float* cur = (c & 1) ? buf1 : buf0; LAS float* nxt = (c & 1) ? buf0 : buf1;
            LAS float* yst = (LAS float*)(lds + YST_OFF_B) + (c & 1) * 256;
            if (is_loader) { if (c + 1 < T / SCH) { scan_commit(R, nxt, lt); if (c + 2 < T / SCH) scan_issue(R, gvec, gv, gsc, c + 2, lt); }
                if (c >= 1 && widx == 0) scan_flush_y((LAS const float*)(lds + YST_OFF_B) + ((c - 1) & 1) * 256, ybase + (size_t)((c - 1) * SCH) * MIXB, lane);
                if (have) tr_slab_store(sl, sv, scrw, lane);
                const int slab = (c + 1) * (int)gridDim.x * 4 + lw; have = (c + 1 < T / SCH) && (slab < nslab);
                if (have) { sl = tr_decode(P, (l + 1) * TR_PER_L + (slab >> 2)); sl.k0 += 16 * (slab & 3); tr_slab_load(sl, sv, lane); } }
            else {
#define SCAN_LD(pp, V1, V2, V3, V4, U1, U2, U3, U4, U5, v1, v2, ca, cb) \
                LAS const float* vb_##V1 = cur + (pp) * 576 + cl * 2; \
                V1 = *(LAS const f32x2v*)(vb_##V1); V2 = *(LAS const f32x2v*)(vb_##V1 + 64); V3 = *(LAS const f32x2v*)(vb_##V1 + 128); V4 = *(LAS const f32x2v*)(vb_##V1 + 192); \
                U1 = *(LAS const f32x2v*)(vb_##V1 + 256); U2 = *(LAS const f32x2v*)(vb_##V1 + 320); U3 = *(LAS const f32x2v*)(vb_##V1 + 384); U4 = *(LAS const f32x2v*)(vb_##V1 + 448); U5 = *(LAS const f32x2v*)(vb_##V1 + 512); \
                v1 = cur[SVOFF + (2 * (pp)) * 8 + il]; v2 = cur[SVOFF + (2 * (pp) + 1) * 8 + il]; \
                ca = *(LAS const f32x2v*)(cur + SCOFF + (pp) * 12); cb = *(LAS const f32x4*)(cur + SCOFF + (pp) * 12 + ycoef);
                f32x2v V1, V2, V3, V4, U1, U2, U3, U4, U5; float v1, v2; f32x2v ca; f32x4 cb;
                { SCAN_LD(0, V1, V2, V3, V4, U1, U2, U3, U4, U5, v1, v2, ca, cb) }
#pragma unroll 8
                for (int p = 0; p < SCH / 2; ++p) {
                    const int pn = (p + 1 < SCH / 2) ? p + 1 : p;
                    f32x2v nV1, nV2, nV3, nV4, nU1, nU2, nU3, nU4, nU5; float nv1, nv2; f32x2v nca; f32x4 ncb;
                    { SCAN_LD(pn, nV1, nV2, nV3, nV4, nU1, nU2, nU3, nU4, nU5, nv1, nv2, nca, ncb) }
                    const float d0 = S0 * V1[0] + S1 * V1[1], d1 = S0 * V2[0] + S1 * V2[1], d2 = S0 * V3[0] + S1 * V3[1], d3 = S0 * V4[0] + S1 * V4[1];
                    const float t0 = v1 * U3[0] + v2 * U5[0], t1 = v1 * U3[1] + v2 * U5[1];
                    const float u01 = (o1 ? d1 : d0) + dppf<0xB1>(o1 ? d0 : d1);
                    const float u23 = (o1 ? d3 : d2) + dppf<0xB1>(o1 ? d2 : d3);
                    float u = (o2 ? u23 : u01) + dppf<0x4E>(o2 ? u01 : u23);
                    u += dppf<0x124>(u); u += dppf<0x128>(u);
                    u = swap16_sum(u);
                    const float sa1 = dppf<0x00>(u);
                    const float sa2 = dppf<0x55>(u) + sa1 * ca[0] + v1 * ca[1];
                    S0 = (S0 * U1[0] + (sa1 * U2[0] + t0)) + sa2 * U4[0];
                    S1 = (S1 * U1[1] + (sa1 * U2[1] + t1)) + sa2 * U4[1];
                    const float ysel = u + sa1 * cb[0] + v1 * cb[1] + sa2 * cb[2] + v2 * cb[3];
                    yrec = ((p & 7) == g8) ? ysel : yrec;
                    if ((p & 7) == 7) { if (o2) yst[((p & 8) * 2 + 2 * g8 + (cls - 2)) * 8 + il] = yrec; }
                    V1 = nV1; V2 = nV2; V3 = nV3; V4 = nV4; U1 = nU1; U2 = nU2; U3 = nU3; U4 = nU4; U5 = nU5; v1 = nv1; v2 = nv2; ca = nca; cb = ncb;
                }
#undef SCAN_LD
            }
            asm volatile("s_waitcnt lgkmcnt(0)" ::: "memory"); __builtin_amdgcn_s_barrier(); asm volatile("" ::: "memory");
        }
        if (is_loader && widx == 0) scan_flush_y((LAS const float*)(lds + YST_OFF_B) + ((T / SCH - 1) & 1) * 256, ybase + (size_t)((T / SCH - 1) * SCH) * MIXB, lane);
    }
}

__device__ __forceinline__ void phase_e3(const Params& P, int l, int wave, int lane) {
    const int gw = blockIdx.x * NWAVES + wave, NGW = gridDim.x * NWAVES;
    const float* YS = (const float*)(P.ws + WS_YS); const bf16* LO = (const bf16*)(P.ws + WS_LORA);
    const float* SV = (const float*)(P.ws + WS_SV); const float* SB = (const float*)(P.ws + WS_SB);
    bf16* MIX = (bf16*)(P.ws + WS_MIX);
    const bool o1 = (lane & 1) != 0, o2 = (lane & 2) != 0;
    for (int wt = gw; wt < (M / 64) * 16; wt += NGW) {
        const int h = wt & 15, m0 = (wt >> 4) * 64, c = h * 64 + lane, b = m0 >> 12;
        const float lnw = P.in[I_LNW][l * MIXB + c], lnb = P.in[I_LNB][l * MIXB + c];
        const size_t row0 = (size_t)(b * 16 + h) * T + (m0 & (T - 1));
        for (int i = 0; i < 64; i += 8) {
            float y[8], v[8], g[8], sb[8];
#pragma unroll
            for (int e = 0; e < 8; ++e) { const int m = m0 + i + e;
                y[e] = YS[(size_t)m * MIXB + c]; v[e] = SV[(row0 + i + e) * 64 + lane]; g[e] = bf2f(LO[(size_t)m * NLORA + 2048 + c]); sb[e] = SB[m * 16 + h]; }
#pragma unroll
            for (int e = 0; e < 8; e += 2) {
                const float u = sum4(y[e], y[e] * y[e], y[e + 1], y[e + 1] * y[e + 1], o1, o2);
                const float s0 = dppf<0x00>(u), q0 = dppf<0x55>(u), s1 = dppf<0xAA>(u), q1 = dppf<0xFF>(u);
                const float mean0 = s0 * (1.f / 64.f), mean1 = s1 * (1.f / 64.f);
                const float var0 = fmaxf(q0 * (1.f / 64.f) - mean0 * mean0, 0.f), var1 = fmaxf(q1 * (1.f / 64.f) - mean1 * mean1, 0.f);
                const float yn0 = (y[e] - mean0) * rsqrtf(var0 + LNX_EPS) * lnw + lnb, yn1 = (y[e + 1] - mean1) * rsqrtf(var1 + LNX_EPS) * lnw + lnb;
                MIX[(size_t)(m0 + i + e) * D + 512 + c] = (bf16)f2bf((yn0 + sb[e] * v[e]) * g[e]);
                MIX[(size_t)(m0 + i + e + 1) * D + 512 + c] = (bf16)f2bf((yn1 + sb[e + 1] * v[e + 1]) * g[e + 1]);
            }
        }
    }
}

template <bool IN_F32, bool OUT_F32>
__device__ __forceinline__ void phase_norm(const void* xin_, void* xout_, const bf16* Y, const float* g1, const float* g2, bf16* XB, int wave, int lane) {
    const int gw = blockIdx.x * NWAVES + wave, NGW = gridDim.x * NWAVES;
    const float* xin32 = (const float*)xin_; const bf16* xin16 = (const bf16*)xin_;
    f32x4 yv[8], xv[8];
    u32x2v yr[8], xr[8];
    if (gw < M) {
#pragma unroll
        for (int j = 0; j < 8; ++j) { yr[j] = ((const u32x2v*)(Y + (size_t)gw * D))[lane + 64 * j];
            if (IN_F32) xv[j] = ((const f32x4*)(xin32 + (size_t)gw * D))[lane + 64 * j]; else xr[j] = ((const u32x2v*)(xin16 + (size_t)gw * D))[lane + 64 * j]; }
    }
    for (int m = gw; m < M; m += NGW) {
        const int mn = (m + NGW < M) ? m + NGW : m;
        u32x2v ny[8], nxr[8]; f32x4 nx[8];
#pragma unroll
        for (int j = 0; j < 8; ++j) { ny[j] = ((const u32x2v*)(Y + (size_t)mn * D))[lane + 64 * j];
            if (IN_F32) nx[j] = ((const f32x4*)(xin32 + (size_t)mn * D))[lane + 64 * j]; else nxr[j] = ((const u32x2v*)(xin16 + (size_t)mn * D))[lane + 64 * j]; }
#pragma unroll
        for (int j = 0; j < 8; ++j) { yv[j] = (f32x4){lo16(yr[j].x), hi16(yr[j].x), lo16(yr[j].y), hi16(yr[j].y)};
            if (!IN_F32) xv[j] = (f32x4){lo16(xr[j].x), hi16(xr[j].x), lo16(xr[j].y), hi16(xr[j].y)}; }
        float s = 0.f;
#pragma unroll
        for (int j = 0; j < 8; ++j) s += (yv[j][0] * yv[j][0] + yv[j][1] * yv[j][1]) + (yv[j][2] * yv[j][2] + yv[j][3] * yv[j][3]);
        const float inv = rsqrtf(wave_sum(s) * (1.f / D) + RMS_EPS);
        float s2 = 0.f;
#pragma unroll
        for (int j = 0; j < 8; ++j) { const f32x4 g = ((const f32x4*)g1)[lane + 64 * j];
            yv[j] = xv[j] + yv[j] * inv * g; s2 += (yv[j][0] * yv[j][0] + yv[j][1] * yv[j][1]) + (yv[j][2] * yv[j][2] + yv[j][3] * yv[j][3]);
            if (OUT_F32) ((f32x4*)((float*)xout_ + (size_t)m * D))[lane + 64 * j] = yv[j];
            else { u32x2v o; o.x = pk2(yv[j][0], yv[j][1]); o.y = pk2(yv[j][2], yv[j][3]); ((u32x2v*)((bf16*)xout_ + (size_t)m * D))[lane + 64 * j] = o; } }
        if (g2) {
            const float inv2 = rsqrtf(wave_sum(s2) * (1.f / D) + RMS_EPS);
#pragma unroll
            for (int j = 0; j < 8; ++j) { const f32x4 g = ((const f32x4*)g2)[lane + 64 * j];
                u32x2v o; o.x = pk2(yv[j][0] * inv2 * g[0], yv[j][1] * inv2 * g[1]); o.y = pk2(yv[j][2] * inv2 * g[2], yv[j][3] * inv2 * g[3]);
                ((u32x2v*)(XB + (size_t)m * D))[lane + 64 * j] = o; }
        }
#pragma unroll
        for (int j = 0; j < 8; ++j) { yr[j] = ny[j]; if (IN_F32) xv[j] = nx[j]; else xr[j] = nxr[j]; }
    }
}

#define XB_TMO      128
#define XB_XCNT(j)  (256  + 64 * (j))
#define XB_XSUB(j)  (1280 + 64 * (j))
#define XB_XGEN(j)  (2304 + 64 * (j))
#define XB_TOP      3328
#define XB_TOPGEN   3392
#define XCD_BAR_WORDS 3456
#define XB_SPIN_CAP (1u << 18)

__device__ __forceinline__ unsigned xb_ld(unsigned* p)              { return __hip_atomic_load(p, __ATOMIC_RELAXED, __HIP_MEMORY_SCOPE_AGENT); }
__device__ __forceinline__ unsigned xb_add(unsigned* p, unsigned v) { return __hip_atomic_fetch_add(p, v, __ATOMIC_RELAXED, __HIP_MEMORY_SCOPE_AGENT); }
__device__ __forceinline__ unsigned xb_xcc_id() { return (unsigned)__builtin_amdgcn_s_getreg((3 << 11) | 20) & 0xFu; }
#define XB_SPIN(cond, bar) do { unsigned _sp = 0; while (cond) { __builtin_amdgcn_s_sleep(1); \
    if ((++_sp & 255u) == 0u) { if (xb_ld(&(bar)[XB_TMO])) break; if (_sp > XB_SPIN_CAP) { atomicAdd(&(bar)[XB_TMO], 1u); break; } } } } while (0)

struct XcdBarrier {
    unsigned* bar; unsigned x;
    volatile LAS unsigned* st;
};

__device__ __forceinline__ XcdBarrier xcd_barrier_post(unsigned* bar, volatile LAS unsigned* st) {
    XcdBarrier b; b.bar = bar; b.x = xb_xcc_id(); b.st = st;
    if (threadIdx.x == 0) (void)xb_add(&bar[XB_XCNT(b.x)], 1u);
    return b;
}
__device__ __forceinline__ void xcd_barrier_complete(unsigned* bar, unsigned x, unsigned& nloc, unsigned& nx) {
    const unsigned G = gridDim.x * gridDim.y * gridDim.z;
    unsigned sum, cnt, mine, sp = 0u;
    for (;;) {
        sum = 0u; cnt = 0u; mine = 0u;
#pragma unroll
        for (unsigned j = 0; j < 16; ++j) { const unsigned c = xb_ld(&bar[XB_XCNT(j)]); sum += c; cnt += (c > 0u) ? 1u : 0u; mine = (j == x) ? c : mine; }
        if (sum == G) break;
        __builtin_amdgcn_s_sleep(1);
        if ((++sp & 255u) == 0u) { if (xb_ld(&bar[XB_TMO])) break; if (sp > XB_SPIN_CAP) { atomicAdd(&bar[XB_TMO], 1u); break; } }
    }
    nloc = mine > 0u ? mine : 1u; nx = cnt > 0u ? cnt : 1u;
}

__device__ __forceinline__ void xcd_barrier(const XcdBarrier& b) {
    asm volatile("s_waitcnt vmcnt(0)" ::: "memory");
    __syncthreads();
    if (threadIdx.x == 0) {
        unsigned* bar = b.bar;
        __builtin_amdgcn_s_waitcnt(0);
        unsigned nloc = b.st[0], nx = b.st[1];
        if (nloc == 0u) { xcd_barrier_complete(bar, b.x, nloc, nx); b.st[0] = nloc; b.st[1] = nx; }
        const unsigned old = xb_add(&bar[XB_XSUB(b.x)], 1u);
        const unsigned gen = old / nloc;
        if (old + 1u == (gen + 1u) * nloc) {
            __builtin_amdgcn_fence(__ATOMIC_RELEASE, "agent");
            asm volatile("s_waitcnt vmcnt(0)" ::: "memory");
            const unsigned og = xb_add(&bar[XB_TOP], 1u);
            const unsigned tg = og / nx;
            if (og + 1u == (tg + 1u) * nx) xb_add(&bar[XB_TOPGEN], 1u);
            else XB_SPIN(xb_ld(&bar[XB_TOPGEN]) == tg, bar);
            __builtin_amdgcn_fence(__ATOMIC_ACQUIRE, "agent");
            xb_add(&bar[XB_XGEN(b.x)], 1u);
            asm volatile("s_waitcnt vmcnt(0)" ::: "memory");
        } else {
            XB_SPIN(xb_ld(&bar[XB_XGEN(b.x)]) == gen, bar);
            __builtin_amdgcn_fence(__ATOMIC_ACQUIRE, "agent");
            asm volatile("s_waitcnt vmcnt(0)" ::: "memory");
        }
    }
    __syncthreads();
}


template <class Epi> __device__ __forceinline__ void run_gemm(LAS unsigned char* lds, const bf16* A, const bf16* Bt, int N, int K, const Epi& E, int wnt = 0, int wks = 0x7fffffff, int wko = 0) {
    pg8::Gemm g{A, Bt, M, N, K, wnt, wks, wko}; pg8::StaticOrder S; S.init(M, N, (int)gridDim.x, (int)blockIdx.x);
    pg8::gemm_phase<Epi, pg8::StaticOrder, true, true>(lds, g, S, E);
}

__global__ void __launch_bounds__(NWAVES * 64, 2) trunk_fwd(Params P) {
    extern __shared__ __attribute__((aligned(16))) unsigned char lds_raw[];
    LAS unsigned char* lds = (LAS unsigned char*)lds_raw;
    cg::grid_group grid = cg::this_grid();
    if (threadIdx.x < 4) ((LAS unsigned*)(lds + LDS_BAR_OFF))[threadIdx.x] = 0u;
    __syncthreads();
    const XcdBarrier xbar = xcd_barrier_post((unsigned*)(P.ws + WS_CTL), (volatile LAS unsigned*)(lds + LDS_BAR_OFF));
    if (P.ph_hi - P.ph_lo > 1) grid.sync();
    unsigned char* ws = P.ws;
    for (int ph = P.ph_lo; ph < P.ph_hi; ++ph) {
        int tid = threadIdx.x; asm volatile("" : "+v"(tid));
        const int lane = tid & 63, wave = __builtin_amdgcn_readfirstlane(tid >> 6);
        if (ph == 0) phase0(P, lds, wave, lane);
        else {
            const int l = (ph - 1) / NPH, k = (ph - 1) % NPH;
            if (k == 0 || k == 8 || k == 2 || k == 6 || k == 9) {
                const bf16* A = (k == 0 || k == 8) ? (const bf16*)(ws + WS_XB) : ((k == 2) ? (const bf16*)(ws + WS_ALORA) : ((k == 6) ? (const bf16*)(ws + WS_MIX) : (const bf16*)(ws + WS_U)));
                const bf16* Bt = (k == 0) ? (const bf16*)(ws + WS_WIN) + (size_t)l * NP * D : ((k == 8) ? (const bf16*)(ws + WS_WUP) + (size_t)l * FF * D
                               : ((k == 2) ? (const bf16*)(ws + WS_WLORA) + (size_t)l * NLORA * KLORA : ((k == 6) ? (const bf16*)(ws + WS_WOUT) + (size_t)l * D * D : (const bf16*)(ws + WS_WDN) + (size_t)l * D * FF)));
                const int N = (k == 0) ? NP : ((k == 8) ? FF : ((k == 2) ? NLORA : D)), K = (k == 2) ? KLORA : ((k == 9) ? FF : D);
                bf16* O = (bf16*)(ws + ((k == 0) ? WS_P : ((k == 8) ? WS_U : ((k == 2) ? WS_LORA : WS_Y))));
                pg8::EpiBf16 E{O, N, (k == 8) ? 1 : 0};
                run_gemm(lds, A, Bt, N, K, E, (k == 2) ? 4 : 0, (k == 2) ? 8 : 0x7fffffff, (k == 2) ? 192 : 0);
            } else if (k == 1) phase_e1(P, l, lds, wave, lane);
            else if (k == 3) phase_e2(P, l, wave, lane);
            else if (k == 4) phase_scan(P, l, lds, wave, lane);
            else if (k == 5) phase_e3(P, l, wave, lane);
            else if (k == 7) { if (l == 0) phase_norm<true, false>(P.in[I_X], ws + WS_XR, (const bf16*)(ws + WS_Y), P.in[I_NMIXPOST] + l * D, P.in[I_NMLPPRE] + l * D, (bf16*)(ws + WS_XB), wave, lane);
                               else phase_norm<false, false>(ws + WS_XR, ws + WS_XR, (const bf16*)(ws + WS_Y), P.in[I_NMIXPOST] + l * D, P.in[I_NMLPPRE] + l * D, (bf16*)(ws + WS_XB), wave, lane); }
            else   { if (l + 1 < L) phase_norm<false, false>(ws + WS_XR, ws + WS_XR, (const bf16*)(ws + WS_Y), P.in[I_NMLPPOST] + l * D, P.in[I_NMIXPRE] + (l + 1) * D, (bf16*)(ws + WS_XB), wave, lane);
                                 else phase_norm<false, true>(ws + WS_XR, P.out, (const bf16*)(ws + WS_Y), P.in[I_NMLPPOST] + l * D, nullptr, (bf16*)(ws + WS_XB), wave, lane); }
        }
        if (ph + 1 < P.ph_hi) xcd_barrier(xbar);
        else if (false) {
            asm volatile("s_waitcnt vmcnt(0) lgkmcnt(0)" ::: "memory");
            __syncthreads();
            if (tid == 0) { __builtin_amdgcn_fence(__ATOMIC_RELEASE, "agent"); asm volatile("s_waitcnt vmcnt(0)" ::: "memory"); }
            grid.sync();
            if (tid == 0) { __builtin_amdgcn_fence(__ATOMIC_ACQUIRE, "agent"); asm volatile("s_waitcnt vmcnt(0)" ::: "memory"); }
            __syncthreads();
        }
    }
}

#pragma clang attribute pop
#ifndef MULTI_LAUNCH
#define MULTI_LAUNCH 0
#endif
extern "C" void kernel_launch(void* const* d_in, const int* in_sizes, int n_in, void* d_out, int out_size, void* d_ws, size_t ws_size, hipStream_t stream) {
    static int grid = 0;
    if (grid == 0) {
        int dev = 0, cus = 0, per_cu = 0;
        (void)hipGetDevice(&dev);
        (void)hipDeviceGetAttribute(&cus, hipDeviceAttributeMultiprocessorCount, dev);
        if (hipFuncSetAttribute((const void*)trunk_fwd, hipFuncAttributeMaxDynamicSharedMemorySize, LDS_BYTES) != hipSuccess) fprintf(stderr, "kernel_launch: hipFuncSetAttribute failed\n");
        if (hipOccupancyMaxActiveBlocksPerMultiprocessor(&per_cu, (const void*)trunk_fwd, NWAVES * 64, LDS_BYTES) != hipSuccess || per_cu < 1) { fprintf(stderr, "kernel_launch: occupancy query gave %d\n", per_cu); per_cu = 1; }
        (void)hipGetLastError();
        grid = cus * per_cu;
        if (n_in != 26 || ws_size < WS_END) fprintf(stderr, "kernel_launch: unexpected n_in %d / ws_size %zu (need %zu)\n", n_in, ws_size, (size_t)WS_END);
    }
    (void)hipMemsetAsync((char*)d_ws + WS_CTL, 0, CTL_BYTES, stream);
    Params p{};
    for (int i = 0; i < 26; ++i) p.in[i] = (const float*)d_in[i];
    p.out = (float*)d_out; p.ws = (unsigned char*)d_ws;
    const int nph = 1 + L * NPH;
#if MULTI_LAUNCH
    for (int ph = 0; ph < nph; ++ph) { p.ph_lo = ph; p.ph_hi = ph + 1; hipLaunchKernelGGL(trunk_fwd, dim3(grid), dim3(NWAVES * 64), LDS_BYTES, stream, p); }
#else
    p.ph_lo = 0; p.ph_hi = nph;
    void* args[] = {&p};
    hipError_t e = hipLaunchCooperativeKernel((const void*)trunk_fwd, dim3(grid), dim3(NWAVES * 64), args, LDS_BYTES, stream);
    if (e != hipSuccess) fprintf(stderr, "cooperative launch failed: %s (grid %d)\n", hipGetErrorString(e), grid);
#endif
}
```

```cpp
#include <hip/hip_runtime.h>
#include <hip/hip_cooperative_groups.h>
#include <cstdio>
#include <cstdint>
namespace cg = cooperative_groups;
#pragma clang attribute push(__attribute__((target("no-packed-fp32-ops"))), apply_to = function)
namespace pg8 {
#define PG8_LAS __attribute__((address_space(3)))
typedef unsigned short bf16_t;
typedef short bf16x8 __attribute__((ext_vector_type(8)));
typedef float f32x4 __attribute__((ext_vector_type(4)));
typedef unsigned u32x4 __attribute__((ext_vector_type(4)));
constexpr int BM = 256, BK = 64, HALF = 128, HTB = HALF * BK * 2  , STAGE_BYTES = 8 * HTB, NXCD = 8, WGM = 8;

__host__ __device__ __forceinline__ int lds_byte(int r, int c) { const int st = (r >> 4) * 2 + (c >> 5), rr = r & 15, cc = c & 31, ob = rr * 64 + cc * 2; return st * 1024 + (ob ^ (((ob >> 9) & 1) << 5)); }
__host__ __device__ __forceinline__ void stage_rc(int b, int& R, int& C) { const int st = b / 1024, sb = b % 1024, swz = sb ^ (((sb >> 9) & 1) << 5); R = (st >> 1) * 16 + swz / 64; C = (st & 1) * 32 + (swz % 64) / 2; }
__host__ __device__ __forceinline__ int perm32(int rho) { const int n = rho >> 4, i = rho & 15; return 8 * (i >> 2) + 4 * n + (i & 3); }

struct Unit { int pm, pn; };
struct Gemm { const bf16_t* A; const bf16_t* Bt; int M, N, K; int nt, ksplit, koff; };

struct StaticOrder {
    int nM, nN, nwg, G, c;
    __host__ __device__ void init(int M, int N, int G_, int c_) { nM = M / BM; nN = N / BM; nwg = nM * nN; G = G_; c = c_; }
    __host__ __device__ bool next(int i, Unit& u) const {
        const long L = (long)i * G + c; if (L >= nwg) return false;
        int wgid = (int)L; { const int q = nwg / NXCD, r = nwg % NXCD, xcd = wgid % NXCD, off = wgid / NXCD; wgid = (xcd < r ? xcd * (q + 1) : r * (q + 1) + (xcd - r) * q) + off; }
        const int nig = WGM * nN, gid = wgid / nig, fm = gid * WGM, gsz = (nM - fm) < WGM ? (nM - fm) : WGM;
        u.pm = fm + ((wgid % nig) % gsz); u.pn = (wgid % nig) / gsz; return true;
    }
    __device__ __forceinline__ void a_ready(const Unit&) const {}
    __device__ __forceinline__ void done(const Unit&) const {}
};

__device__ __forceinline__ unsigned cvt_pk_bf16(float lo, float hi) { unsigned r; asm volatile("v_cvt_pk_bf16_f32 %0, %1, %2" : "=v"(r) : "v"(lo), "v"(hi)); return r; }
typedef float f32x2 __attribute__((ext_vector_type(2)));
__device__ __forceinline__ f32x2 gelu_pk(f32x2 v) {
    const f32x2 av = __builtin_elementwise_abs(v), d = av * 0.2316418882f + 1.0f;
    f32x2 t; t.x = __builtin_amdgcn_rcpf(d.x); t.y = __builtin_amdgcn_rcpf(d.y);
    f32x2 q = t * 0.5307027145f + (-0.7265760135f); q = q * t + 0.7107068705f; q = q * t + (-0.142248368f); q = q * t + 0.127414796f; q = q * t;
    const f32x2 s = (v * v) * (-0.72134752044f);
    f32x2 e; e.x = __builtin_amdgcn_exp2f(s.x); e.y = __builtin_amdgcn_exp2f(s.y);
    const f32x2 m = v * (q * e), r = v - m;
    f32x2 o; o.x = v.x < 0.f ? m.x : r.x; o.y = v.y < 0.f ? m.y : r.y; return o;
}
struct EpiF32 {
    static constexpr bool PERM = false, AFTER_DRAIN = false;
    float* C; int ldc;
    __device__ __forceinline__ void operator()(const f32x4 (&acc)[2][2][4][2], const Unit& u, int wr, int wc, int fr, int fq) const {
        const int row0 = u.pm * BM + wr * 64 + fr, col0 = u.pn * BM + wc * 32 + 4 * fq;
#pragma unroll
        for (int ai = 0; ai < 2; ++ai)
#pragma unroll
            for (int m = 0; m < 4; ++m) { float* rowp = C + (size_t)(row0 + ai * HALF + m * 16) * ldc + col0;
#pragma unroll
                for (int bj = 0; bj < 2; ++bj)
#pragma unroll
                    for (int n = 0; n < 2; ++n) *(f32x4*)(rowp + bj * HALF + n * 16) = acc[ai][bj][m][n]; }
    }
};
struct EpiBf16 {
    static constexpr bool PERM = true, AFTER_DRAIN = false;
    bf16_t* O; int ldc; int relu2;
    __device__ __forceinline__ void operator()(const f32x4 (&acc)[2][2][4][2], const Unit& u, int wr, int wc, int fr, int fq) const {
        const int row0 = u.pm * BM + wr * 64 + fr; const int col0 = u.pn * BM + wc * 32 + 8 * fq;
#pragma unroll
        for (int ai = 0; ai < 2; ++ai)
#pragma unroll
            for (int m = 0; m < 4; ++m) { bf16_t* rowp = O + (size_t)(row0 + ai * HALF + m * 16) * ldc + col0;
#pragma unroll
                for (int bj = 0; bj < 2; ++bj) { f32x4 v0 = acc[ai][bj][m][0], v1 = acc[ai][bj][m][1];
                    if (relu2) {
#pragma unroll
                        for (int j = 0; j < 4; ++j) { const float a = fmaxf(v0[j], 0.f), b = fmaxf(v1[j], 0.f); v0[j] = a * a; v1[j] = b * b; } }
                    u32x4 w; w.x = cvt_pk_bf16(v0[0], v0[1]); w.y = cvt_pk_bf16(v0[2], v0[3]); w.z = cvt_pk_bf16(v1[0], v1[1]); w.w = cvt_pk_bf16(v1[2], v1[3]);
                    *(u32x4*)(rowp + bj * HALF) = w; } }
    }
};

template <class Epi, class Sched, bool ALIGN_EPI = false, bool SP2 = false>
__device__ __forceinline__ void gemm_phase(PG8_LAS unsigned char* lds, const Gemm g, const Sched& S, const Epi& E) {
    int tid_ = threadIdx.x; asm volatile("" : "+v"(tid_)); const int tid = tid_, wid = __builtin_amdgcn_readfirstlane(tid >> 6), lane = tid & 63, wr = wid >> 2, wc = wid & 3, fr = lane & 15, fq = lane >> 4;
    const int K = g.K, nt = g.nt ? g.nt : K / BK;
    unsigned voffA[2], voffB[2];
#pragma unroll
    for (int i = 0; i < 2; ++i) { int R, C; stage_rc(tid * 16 + i * 8192, R, C); const int Rb = Epi::PERM ? ((R & ~31) + perm32(R & 31)) : R;
        voffA[i] = (unsigned)(R * K + C) * 2u; voffB[i] = (unsigned)(Rb * K + C) * 2u; }
    const size_t kstep = (size_t)(BK * 2);
    const size_t hstep = (size_t)HALF * K * 2;
    const size_t tstep = 2 * hstep;
    const unsigned ldsw = (unsigned)wid * 1024u;
    const int aoff = lds_byte(wr * 64 + fr, fq * 8), boff = lds_byte(wc * 32 + fr, fq * 8);
#define PG8_SA(b, h) (((b) * 2 + (h)) * HTB)
#define PG8_SB(b, h) ((4 + (b) * 2 + (h)) * HTB)
#define PG8_STAGE(bufoff, gbase, voff) do { _Pragma("unroll") for (int _i = 0; _i < 2; ++_i) \
        __builtin_amdgcn_global_load_lds((const unsigned*)((const char*)(gbase) + (voff)[_i]), (PG8_LAS unsigned*)(lds + (bufoff) + ldsw + _i * 8192), 16, 0, 0); } while (0)
#define PG8_LDA(dst, b, h) do { _Pragma("unroll") for (int m = 0; m < 4; ++m) _Pragma("unroll") for (int k = 0; k < 2; ++k) dst[m][k] = *(const PG8_LAS bf16x8*)(lds + PG8_SA(b, h) + aoff + m * 2048 + k * 1024); } while (0)
#define PG8_LDB(dst, b, h) do { _Pragma("unroll") for (int n = 0; n < 2; ++n) _Pragma("unroll") for (int k = 0; k < 2; ++k) dst[n][k] = *(const PG8_LAS bf16x8*)(lds + PG8_SB(b, h) + boff + n * 2048 + k * 1024); } while (0)
#define PG8_MMA(ai, bj, At, Bt) do { __builtin_amdgcn_s_setprio(1); _Pragma("unroll") for (int m = 0; m < 4; ++m) _Pragma("unroll") for (int n = 0; n < 2; ++n) _Pragma("unroll") for (int k = 0; k < 2; ++k) \
        acc[ai][bj][m][n] = __builtin_amdgcn_mfma_f32_16x16x32_bf16(Bt[n][k], At[m][k], acc[ai][bj][m][n], 0, 0, 0); __builtin_amdgcn_s_setprio(0); } while (0)
#define PG8_WAIT_V(n) asm volatile("s_waitcnt vmcnt(" #n ")" ::: "memory")
#define PG8_WAIT_L(n) asm volatile("s_waitcnt lgkmcnt(" #n ")" ::: "memory")
#define PG8_BAR __builtin_amdgcn_s_barrier()
#define PG8_SCHED __builtin_amdgcn_sched_barrier(0)
    Unit cur, nxt; int ui = 0;
    if (!S.next(0, cur)) return;
    f32x4 acc[2][2][4][2];
#pragma unroll
    for (int a = 0; a < 2; ++a)
#pragma unroll
        for (int b = 0; b < 2; ++b)
#pragma unroll
            for (int m = 0; m < 4; ++m)
#pragma unroll
                for (int n = 0; n < 2; ++n) acc[a][b][m][n] = (f32x4){0.f, 0.f, 0.f, 0.f};
    bf16x8 At[4][2], B0[2][2], B1[2][2];
    const size_t ko0 = (cur.pn >= g.ksplit) ? (size_t)g.koff * 2 : 0;
    const char* cA = (const char*)g.A + (size_t)cur.pm * tstep + ko0; const char* cB = (const char*)g.Bt + (size_t)cur.pn * tstep + ko0;
    S.a_ready(cur);
    if constexpr (SP2) {
        PG8_STAGE(PG8_SB(0, 0), cB, voffB); PG8_STAGE(PG8_SB(0, 1), cB + hstep, voffB); PG8_STAGE(PG8_SA(0, 0), cA, voffA); PG8_STAGE(PG8_SA(0, 1), cA + hstep, voffA);
        if (wr == 1) PG8_BAR;
        PG8_WAIT_V(2); PG8_BAR;
        PG8_STAGE(PG8_SB(1, 0), cB + kstep, voffB); PG8_STAGE(PG8_SA(1, 0), cA + kstep, voffA); PG8_STAGE(PG8_SB(1, 1), cB + hstep + kstep, voffB);
        PG8_WAIT_V(6); PG8_BAR;
    } else {
        PG8_STAGE(PG8_SB(0, 0), cB, voffB); PG8_STAGE(PG8_SA(0, 0), cA, voffA); PG8_STAGE(PG8_SB(0, 1), cB + hstep, voffB); PG8_STAGE(PG8_SA(0, 1), cA + hstep, voffA);
        if (wr == 1) PG8_BAR;
        PG8_WAIT_V(4); PG8_BAR;
        PG8_STAGE(PG8_SB(1, 0), cB + kstep, voffB); PG8_STAGE(PG8_SA(1, 0), cA + kstep, voffA); PG8_STAGE(PG8_SB(1, 1), cB + hstep + kstep, voffB);
        PG8_WAIT_V(6); PG8_BAR;
    }
    for (;;) {
        const bool has_next = S.next(ui + 1, nxt);
        const size_t ko1 = (has_next && nxt.pn >= g.ksplit) ? (size_t)g.koff * 2 : 0;
        const char* nA = has_next ? (const char*)g.A + (size_t)nxt.pm * tstep + ko1 : cA; const char* nB = has_next ? (const char*)g.Bt + (size_t)nxt.pn * tstep + ko1 : cB;
        for (int t = 0; t < nt; t += 2) {
            const bool last = (t == nt - 2);
            const char* a1 = cA + (size_t)(t + 1) * kstep;
            const char* a2 = last ? nA : cA + (size_t)(t + 2) * kstep; const char* b2 = last ? nB : cB + (size_t)(t + 2) * kstep;
            const char* a3 = a2 + kstep; const char* b3 = b2 + kstep;
            if (last && has_next) S.a_ready(nxt);
            if constexpr (SP2) {
            PG8_LDB(B0, 0, 0); PG8_LDB(B1, 0, 1); PG8_SCHED; PG8_LDA(At, 0, 0); PG8_STAGE(PG8_SA(1, 1), a1 + hstep, voffA);
            PG8_WAIT_V(8); PG8_WAIT_L(0); PG8_BAR; PG8_MMA(0, 0, At, B0); PG8_MMA(0, 1, At, B1); PG8_BAR; PG8_SCHED;
            PG8_LDA(At, 0, 1); PG8_STAGE(PG8_SB(0, 0), b2, voffB); PG8_STAGE(PG8_SB(0, 1), b2 + hstep, voffB); PG8_STAGE(PG8_SA(0, 0), a2, voffA);
            PG8_WAIT_V(8); PG8_WAIT_L(0); PG8_BAR; PG8_MMA(1, 0, At, B0); PG8_MMA(1, 1, At, B1); PG8_BAR; PG8_SCHED;
            PG8_LDB(B0, 1, 0); PG8_LDB(B1, 1, 1); PG8_SCHED; PG8_LDA(At, 1, 0); PG8_STAGE(PG8_SA(0, 1), a2 + hstep, voffA);
            PG8_WAIT_V(8); PG8_WAIT_L(0); PG8_BAR; PG8_MMA(0, 0, At, B0); PG8_MMA(0, 1, At, B1); PG8_BAR; PG8_SCHED;
            PG8_LDA(At, 1, 1); PG8_STAGE(PG8_SB(1, 0), b3, voffB); PG8_STAGE(PG8_SB(1, 1), b3 + hstep, voffB); PG8_STAGE(PG8_SA(1, 0), a3, voffA);
            PG8_WAIT_V(8); PG8_WAIT_L(0); PG8_BAR; PG8_MMA(1, 0, At, B0); PG8_MMA(1, 1, At, B1); PG8_BAR; PG8_SCHED;
            } else {
            PG8_LDB(B0, 0, 0); PG8_SCHED; PG8_LDA(At, 0, 0); PG8_STAGE(PG8_SA(1, 1), a1 + hstep, voffA);
            PG8_WAIT_L(8); PG8_BAR; PG8_WAIT_L(0); PG8_MMA(0, 0, At, B0); PG8_BAR; PG8_SCHED;
            PG8_LDB(B1, 0, 1); PG8_STAGE(PG8_SB(0, 0), b2, voffB);
            PG8_BAR; PG8_WAIT_L(0); PG8_MMA(0, 1, At, B1); PG8_BAR;
            PG8_LDA(At, 0, 1); PG8_STAGE(PG8_SA(0, 0), a2, voffA);
            PG8_BAR; PG8_WAIT_L(0); PG8_MMA(1, 0, At, B0); PG8_BAR; PG8_SCHED;
            PG8_STAGE(PG8_SB(0, 1), b2 + hstep, voffB);
            PG8_WAIT_V(6); PG8_BAR; PG8_MMA(1, 1, At, B1); PG8_BAR;
            PG8_LDB(B0, 1, 0); PG8_SCHED; PG8_LDA(At, 1, 0); PG8_STAGE(PG8_SA(0, 1), a2 + hstep, voffA);
            PG8_WAIT_L(8); PG8_BAR; PG8_WAIT_L(0); PG8_MMA(0, 0, At, B0); PG8_BAR; PG8_SCHED;
            PG8_LDB(B1, 1, 1); PG8_STAGE(PG8_SB(1, 0), b3, voffB);
            PG8_BAR; PG8_WAIT_L(0); PG8_MMA(0, 1, At, B1); PG8_BAR;
            PG8_LDA(At, 1, 1); PG8_STAGE(PG8_SA(1, 0), a3, voffA);
            PG8_BAR; PG8_WAIT_L(0); PG8_MMA(1, 0, At, B0); PG8_BAR; PG8_SCHED;
            PG8_STAGE(PG8_SB(1, 1), b3 + hstep, voffB);
            PG8_WAIT_V(6); PG8_BAR; PG8_MMA(1, 1, At, B1); PG8_BAR;
            }
        }
        if constexpr (ALIGN_EPI) { if (wr == 0) PG8_BAR; }
        if constexpr (!Epi::AFTER_DRAIN) { E(acc, cur, wr, wc, fr, fq); S.done(cur); }
        if (!has_next) break;
        PG8_WAIT_V(0);
#pragma unroll
        for (int a = 0; a < 2; ++a)
#pragma unroll
            for (int b = 0; b < 2; ++b)
#pragma unroll
                for (int m = 0; m < 4; ++m)
#pragma unroll
                    for (int n = 0; n < 2; ++n) acc[a][b][m][n] = (f32x4){0.f, 0.f, 0.f, 0.f};
        cur = nxt; cA = nA; cB = nB; ++ui;
        if constexpr (ALIGN_EPI) { if (wr == 1) PG8_BAR; }
    }
    PG8_WAIT_V(0);
    if constexpr (!ALIGN_EPI) { if (wr == 0) PG8_BAR; }
    PG8_BAR;
    if constexpr (Epi::AFTER_DRAIN) { E.fused(acc, cur, wr, wc, fr, fq, lds, wid, lane); S.done(cur); }
#undef PG8_SA
#undef PG8_SB
#undef PG8_STAGE
#undef PG8_LDA
#undef PG8_LDB
#undef PG8_MMA
#undef PG8_WAIT_V
#undef PG8_WAIT_L
#undef PG8_BAR
#undef PG8_SCHED
}
}
#define LAS __attribute__((address_space(3)))
typedef unsigned short bf16;
typedef float f32x4 __attribute__((ext_vector_type(4)));
typedef float f32x2v __attribute__((ext_vector_type(2)));
typedef unsigned u32x4v __attribute__((ext_vector_type(4)));
typedef unsigned u32x2v __attribute__((ext_vector_type(2)));
typedef short bf16x8 __attribute__((ext_vector_type(8)));

constexpr int NB = 2, T = 4096, M = NB * T, D = 2048, L = 4;
constexpr int MIXA = 512, MIXB = 1024, MIXC = 512, NIN = 6080, NP = 6144, FF = 8192;
constexpr int RW0 = 1024;
constexpr int PC0 = 1024 + 3520;
constexpr int NLORA = 3072, KLORA = 512;
constexpr int NPH = 11;
constexpr int NWAVES = 8;
constexpr int LDS_BYTES = 147456;
constexpr float RMS_EPS = 1e-6f, LNX_EPS = 64e-5f;

constexpr size_t MiB = 1u << 20;
constexpr size_t WS_WIN = 0;
constexpr size_t WS_WOUT = WS_WIN + 96 * MiB;
constexpr size_t WS_WUP = WS_WOUT + 32 * MiB;
constexpr size_t WS_WDN = WS_WUP + 128 * MiB;
constexpr size_t WS_WLORA = WS_WDN + 128 * MiB;
constexpr size_t WS_XB = WS_WLORA + 12 * MiB;
constexpr size_t WS_Y = WS_XB + 32 * MiB;
constexpr size_t WS_MIX = WS_Y + 64 * MiB;
constexpr size_t WS_P = WS_MIX + 32 * MiB;
constexpr size_t WS_ALORA = WS_P + 96 * MiB;
constexpr size_t WS_LORA = WS_ALORA + 8 * MiB;
constexpr size_t WS_SCANIN = WS_LORA + 96 * MiB;
constexpr size_t WS_U = WS_SCANIN;
constexpr size_t WS_SV = WS_SCANIN + 160 * MiB;
constexpr size_t WS_SC = WS_SV + 32 * MiB;
constexpr size_t WS_SB = WS_SC + 3 * MiB;
constexpr size_t WS_YS = WS_SB + 1 * MiB;
constexpr size_t WS_CTL = WS_YS + 32 * MiB;
constexpr size_t CTL_BYTES = 65536;
constexpr size_t WS_XR = WS_CTL + 1 * MiB;
constexpr size_t WS_END = WS_XR + 32 * MiB;
constexpr int LDS_BAR_OFF = LDS_BYTES - 16;

struct Params { const float* in[26]; float* out; unsigned char* ws; int ph_lo, ph_hi; };
enum { I_X = 0, I_NMIXPRE, I_NMIXPOST, I_NMLPPRE, I_NMLPPOST, I_WIN, I_GMVG, I_GMWS, I_GMBS, I_GMOG, I_MU, I_W0, I_WUP, I_A0, I_AUP, I_GUP,
       I_KK, I_KA, I_RK, I_LNW, I_LNB, I_CONV, I_SCOG, I_WOUT, I_MUP, I_MDN };

__device__ __forceinline__ float bf2f(bf16 b) { return __builtin_bit_cast(float, ((unsigned)b) << 16); }
__device__ __forceinline__ unsigned f2bf(float f) { unsigned u = __builtin_bit_cast(unsigned, f); return (u + 0x7fffu + ((u >> 16) & 1u)) >> 16; }
__device__ __forceinline__ unsigned pk2(float lo, float hi) { unsigned r; asm volatile("v_cvt_pk_bf16_f32 %0, %1, %2" : "=v"(r) : "v"(lo), "v"(hi)); return r; }
__device__ __forceinline__ float lo16(unsigned u) { return __builtin_bit_cast(float, u << 16); }
__device__ __forceinline__ float hi16(unsigned u) { return __builtin_bit_cast(float, u & 0xffff0000u); }
template <int CTRL> __device__ __forceinline__ float dppf(float v) {
    return __builtin_bit_cast(float, __builtin_amdgcn_update_dpp(0, __builtin_bit_cast(int, v), CTRL, 0xF, 0xF, true));
}
__device__ __forceinline__ float row16_sum(float v) {
    v += dppf<0xB1>(v); v += dppf<0x4E>(v); v += dppf<0x124>(v); v += dppf<0x128>(v);
    return v;
}
__device__ __forceinline__ float wave_sum(float v) {
    v = row16_sum(v);
    const int iv = __builtin_bit_cast(int, v);
    const float a = __builtin_bit_cast(float, __builtin_amdgcn_readlane(iv, 0)), b = __builtin_bit_cast(float, __builtin_amdgcn_readlane(iv, 16));
    const float c = __builtin_bit_cast(float, __builtin_amdgcn_readlane(iv, 32)), d = __builtin_bit_cast(float, __builtin_amdgcn_readlane(iv, 48));
    return (a + b) + (c + d);
}
__device__ __forceinline__ float sigmoidf_(float x) { return 1.f / (1.f + __expf(-x)); }
__device__ __forceinline__ float gelu_tanh(float x) {
    const float u = 1.5957691216057308f * (x + 0.044715f * x * x * x);
    return x * __builtin_amdgcn_rcpf(1.f + __expf(-u));
}

struct TrItem { const float* W; bf16* WT; int K, N, k0, n0; };
__device__ __forceinline__ void tr_load(const TrItem& t, f32x4 (&v)[16], int lane) {
    const int lr = lane >> 4, lc = (lane & 15) * 4;
#pragma unroll
    for (int i = 0; i < 16; ++i) v[i] = *(const f32x4*)(t.W + (size_t)(t.k0 + 4 * i + lr) * t.N + t.n0 + lc);
}
__device__ __forceinline__ void tr_store(const TrItem& t, const f32x4 (&v)[16], LAS float* scr, int lane) {
    const int lr = lane >> 4, lc = (lane & 15) * 4;
#pragma unroll
    for (int i = 0; i < 16; ++i) { LAS float* s = scr + (4 * i + lr) * 65 + lc; s[0] = v[i][0]; s[1] = v[i][1]; s[2] = v[i][2]; s[3] = v[i][3]; }
    asm volatile("s_waitcnt lgkmcnt(0)" ::: "memory");
    const int c = lane & 7;
#pragma unroll
    for (int j = 0; j < 8; ++j) { const int n = (lane >> 3) + 8 * j; const LAS float* s = scr + (8 * c) * 65 + n;
        u32x4v o; o.x = pk2(s[0 * 65], s[1 * 65]); o.y = pk2(s[2 * 65], s[3 * 65]); o.z = pk2(s[4 * 65], s[5 * 65]); o.w = pk2(s[6 * 65], s[7 * 65]);
        *(u32x4v*)(t.WT + (size_t)(t.n0 + n) * t.K + t.k0 + 8 * c) = o; }
    asm volatile("s_waitcnt lgkmcnt(0)" ::: "memory");
}

constexpr int TR_I_IN = (D / 64) * (NIN / 64), TR_I_O = (D / 64) * (D / 64), TR_I_U = (D / 64) * (FF / 64), TR_I_D = (FF / 64) * (D / 64);
constexpr int TR_PER_L = TR_I_IN + TR_I_O + TR_I_U + TR_I_D;
__device__ __forceinline__ TrItem tr_decode(const Params& P, int it) {
    unsigned char* ws = P.ws;
    const int l = it / TR_PER_L; int r = it % TR_PER_L; TrItem t;
    if (r < TR_I_IN) { t.W = P.in[I_WIN] + (size_t)l * D * NIN; t.WT = (bf16*)(ws + WS_WIN) + (size_t)l * NP * D; t.K = D; t.N = NIN; t.k0 = 64 * (r / (NIN / 64)); t.n0 = 64 * (r % (NIN / 64)); }
    else if ((r -= TR_I_IN) < TR_I_O) { t.W = P.in[I_WOUT] + (size_t)l * D * D; t.WT = (bf16*)(ws + WS_WOUT) + (size_t)l * D * D; t.K = D; t.N = D; t.k0 = 64 * (r / (D / 64)); t.n0 = 64 * (r % (D / 64)); }
    else if ((r -= TR_I_O) < TR_I_U) { t.W = P.in[I_MUP] + (size_t)l * D * FF; t.WT = (bf16*)(ws + WS_WUP) + (size_t)l * FF * D; t.K = D; t.N = FF; t.k0 = 64 * (r / (FF / 64)); t.n0 = 64 * (r % (FF / 64)); }
    else { r -= TR_I_U; t.W = P.in[I_MDN] + (size_t)l * FF * D; t.WT = (bf16*)(ws + WS_WDN) + (size_t)l * D * FF; t.K = FF; t.N = D; t.k0 = 64 * (r / (D / 64)); t.n0 = 64 * (r % (D / 64)); }
    return t;
}
__device__ __forceinline__ void tr_slab_load(const TrItem& t, f32x4 (&v)[4], int lane) {
    const int lr = lane >> 4, lc = (lane & 15) * 4;
#pragma unroll
    for (int i = 0; i < 4; ++i) v[i] = *(const f32x4*)(t.W + (size_t)(t.k0 + 4 * i + lr) * t.N + t.n0 + lc);
}
__device__ __forceinline__ void tr_slab_store(const TrItem& t, const f32x4 (&v)[4], LAS float* scr, int lane) {
    const int lr = lane >> 4, lc = (lane & 15) * 4;
#pragma unroll
    for (int i = 0; i < 4; ++i) *(LAS f32x4*)(scr + (4 * i + lr) * 68 + lc) = v[i];
    asm volatile("s_waitcnt lgkmcnt(0)" ::: "memory");
    const LAS float* s = scr + lane;
    u32x4v o0, o1;
    o0.x = pk2(s[0 * 68], s[1 * 68]); o0.y = pk2(s[2 * 68], s[3 * 68]); o0.z = pk2(s[4 * 68], s[5 * 68]); o0.w = pk2(s[6 * 68], s[7 * 68]);
    o1.x = pk2(s[8 * 68], s[9 * 68]); o1.y = pk2(s[10 * 68], s[11 * 68]); o1.z = pk2(s[12 * 68], s[13 * 68]); o1.w = pk2(s[14 * 68], s[15 * 68]);
    bf16* dst = t.WT + (size_t)(t.n0 + lane) * t.K + t.k0;
    *(u32x4v*)dst = o0; *(u32x4v*)(dst + 8) = o1;
    asm volatile("s_waitcnt lgkmcnt(0)" ::: "memory");
}

__device__ __forceinline__ void rms_row_to_bf16(const float* xrow, const float* gain, bf16* orow, int lane) {
    f32x4 v[8]; float s = 0.f;
#pragma unroll
    for (int j = 0; j < 8; ++j) { v[j] = ((const f32x4*)xrow)[lane + 64 * j]; s += (v[j][0] * v[j][0] + v[j][1] * v[j][1]) + (v[j][2] * v[j][2] + v[j][3] * v[j][3]); }
    const float inv = rsqrtf(wave_sum(s) * (1.f / D) + RMS_EPS);
#pragma unroll
    for (int j = 0; j < 8; ++j) { const f32x4 g = ((const f32x4*)gain)[lane + 64 * j];
        u32x2v o; o.x = pk2(v[j][0] * inv * g[0], v[j][1] * inv * g[1]); o.y = pk2(v[j][2] * inv * g[2], v[j][3] * inv * g[3]);
        ((u32x2v*)orow)[lane + 64 * j] = o; }
}

__device__ __forceinline__ void phase0(const Params& P, LAS unsigned char* lds, int wave, int lane) {
    unsigned char* ws = P.ws;
    LAS float* scr = (LAS float*)(lds + wave * 16640);
    const int gw = blockIdx.x * NWAVES + wave, NGW = gridDim.x * NWAVES;
    const int n_items = ((int)gridDim.x * 4 * (T / 32) >= 4 * TR_PER_L) ? TR_PER_L : L * TR_PER_L;
    if (gw < n_items) {
        TrItem cur = tr_decode(P, gw); f32x4 va[16]; tr_load(cur, va, lane);
        for (int it = gw; it < n_items; it += NGW) {
            const bool more = (it + NGW < n_items);
            const TrItem nxt = tr_decode(P, more ? it + NGW : it);
            f32x4 vb[16]; tr_load(nxt, vb, lane);
            tr_store(cur, va, scr, lane);
            cur = nxt;
#pragma unroll
            for (int i = 0; i < 16; ++i) va[i] = vb[i];
        }
    }
    const int gt = blockIdx.x * 512 + threadIdx.x, NGT = gridDim.x * 512;
    for (int i = gt; i < L * (NP - NIN) * D / 8; i += NGT) { const int l = i / ((NP - NIN) * D / 8), r = i % ((NP - NIN) * D / 8);
        ((u32x4v*)((bf16*)(ws + WS_WIN) + (size_t)l * NP * D + (size_t)NIN * D))[r] = (u32x4v){0u, 0u, 0u, 0u}; }
    for (int i = gt; i < L * NLORA * KLORA; i += NGT) {
        const int l = i / (NLORA * KLORA), r = i % (NLORA * KLORA), n = r / KLORA, k = r % KLORA; float v = 0.f;
        if (n < 1024) { if (k < 96) v = P.in[I_WUP][((size_t)l * 96 + k) * 1024 + n]; }
        else if (n < 2048) { if (k >= 96 && k < 192) v = P.in[I_AUP][((size_t)l * 96 + (k - 96)) * 1024 + (n - 1024)]; }
        else { if (k >= 192 && k < 448) v = P.in[I_GUP][((size_t)l * 256 + (k - 192)) * 1024 + (n - 2048)]; }
        ((bf16*)(ws + WS_WLORA))[i] = (bf16)f2bf(v);
    }
    for (int m = gw; m < M; m += NGW) rms_row_to_bf16(P.in[I_X] + (size_t)m * D, P.in[I_NMIXPRE], (bf16*)(ws + WS_XB) + (size_t)m * D, lane);
}

__device__ __forceinline__ void gmlp_unit(const Params& P, int l, int unit, LAS unsigned char* lds, int wave, int lane) {
    const int g = unit & 3, bc = unit >> 2; const int m0 = bc * 128;
    const bf16* Pp = (const bf16*)(P.ws + WS_P);
    bf16* MIX = (bf16*)(P.ws + WS_MIX);
    constexpr int VS = 136;
    LAS bf16* vT = (LAS bf16*)lds;
    const float* vg = P.in[I_GMVG] + l * MIXA + g * 128;
    const int fr = lane & 15, fq = lane >> 4, t0 = wave * 16;
    const float* Wg = P.in[I_GMWS] + ((size_t)(l * 4 + g) * 128) * 128;
    f32x4 wpre[4][2];
#pragma unroll
    for (int kk = 0; kk < 4; ++kk) { const int kq = (32 * kk <= t0 + 15) ? kk : 0; const float* wp = Wg + (t0 + fr) * 128 + 32 * kq + fq * 8;
        wpre[kk][0] = *(const f32x4*)wp; wpre[kk][1] = *(const f32x4*)(wp + 4); }
    {
        const float g0 = vg[2 * lane], g1 = vg[2 * lane + 1];
        unsigned pvv[16];
#pragma unroll
        for (int i = 0; i < 16; ++i) pvv[i] = *(const unsigned*)(Pp + (size_t)(m0 + wave * 16 + i) * NP + 512 + g * 128 + 2 * lane);
#pragma unroll
        for (int i = 0; i < 16; ++i) { const int s = wave * 16 + i;
            const unsigned pv = pvv[i];
            const float z0 = gelu_tanh(lo16(pv)), z1 = gelu_tanh(hi16(pv));
            const float inv = rsqrtf(wave_sum(z0 * z0 + z1 * z1) * (1.f / 128.f) + RMS_EPS);
            vT[(2 * lane) * VS + s] = (bf16)f2bf(z0 * inv * g0); vT[(2 * lane + 1) * VS + s] = (bf16)f2bf(z1 * inv * g1); }
    }
    __syncthreads();
    bf16 uraw[4][8];
#pragma unroll
    for (int j = 0; j < 4; ++j)
#pragma unroll
        for (int n = 0; n < 8; ++n) uraw[j][n] = Pp[(size_t)(m0 + t0 + 4 * fq + j) * NP + g * 128 + n * 16 + fr];
    f32x4 acc[8];
#pragma unroll
    for (int n = 0; n < 8; ++n) acc[n] = (f32x4){0.f, 0.f, 0.f, 0.f};
#pragma unroll
    for (int kk = 0; kk < 4; ++kk) {
        if (32 * kk > t0 + 15) continue;
        const int trow = t0 + fr, k0 = 32 * kk + fq * 8;
        const f32x4 w0 = wpre[kk][0], w1 = wpre[kk][1];
        float wv[8] = {w0[0], w0[1], w0[2], w0[3], w1[0], w1[1], w1[2], w1[3]};
        bf16x8 a;
#pragma unroll
        for (int j = 0; j < 8; ++j) a[j] = (short)f2bf((k0 + j <= trow) ? wv[j] : 0.f);
#pragma unroll
        for (int n = 0; n < 8; ++n) { const bf16x8 b = *(const LAS bf16x8*)(vT + (n * 16 + fr) * VS + k0);
            acc[n] = __builtin_amdgcn_mfma_f32_16x16x32_bf16(a, b, acc[n], 0, 0, 0); }
    }
    const float* bsg = P.in[I_GMBS] + (l * 4 + g) * 128;
    const float* og = P.in[I_GMOG] + l * MIXA + g * 128;
    float ss[4] = {0.f, 0.f, 0.f, 0.f};
#pragma unroll
    for (int j = 0; j < 4; ++j) { const int t = t0 + 4 * fq + j; const float bias = bsg[t];
#pragma unroll
        for (int n = 0; n < 8; ++n) { const float u = gelu_tanh(bf2f(uraw[j][n]));
            const float o = u * (acc[n][j] + bias); acc[n][j] = o; ss[j] += o * o; } }
#pragma unroll
    for (int j = 0; j < 4; ++j) { float s = ss[j]; s += dppf<0xB1>(s); s += dppf<0x4E>(s); s += dppf<0x124>(s); s += dppf<0x128>(s); ss[j] = rsqrtf(s * (1.f / 128.f) + RMS_EPS); }
#pragma unroll
    for (int n = 0; n < 8; ++n) { const float gn = og[n * 16 + fr];
#pragma unroll
        for (int j = 0; j < 4; ++j) { const int t = t0 + 4 * fq + j; MIX[(size_t)(m0 + t) * D + g * 128 + n * 16 + fr] = (bf16)f2bf(acc[n][j] * ss[j] * gn); } }
    __syncthreads();
}

__device__ __forceinline__ void unpack8(const u32x4v u, float (&f)[8]) {
    f[0] = lo16(u.x); f[1] = hi16(u.x); f[2] = lo16(u.y); f[3] = hi16(u.y); f[4] = lo16(u.z); f[5] = hi16(u.z); f[6] = lo16(u.w); f[7] = hi16(u.w);
}

__device__ __forceinline__ void phase_e1(const Params& P, int l, LAS unsigned char* lds, int wave, int lane) {
    for (int unit = blockIdx.x; unit < 256; unit += gridDim.x) gmlp_unit(P, l, unit, lds, wave, lane);
    const int gw = blockIdx.x * NWAVES + wave, NGW = gridDim.x * NWAVES;
    const bf16* Pp = (const bf16*)(P.ws + WS_P);
    bf16* MIX = (bf16*)(P.ws + WS_MIX);
    bf16* AL = (bf16*)(P.ws + WS_ALORA);
    {
        const float* cw = P.in[I_CONV] + (size_t)l * 3 * MIXC; const float* sg = P.in[I_SCOG] + l * MIXC;
        float w0[8], w1[8], w2[8], gn[8];
#pragma unroll
        for (int e = 0; e < 8; ++e) { w0[e] = cw[8 * lane + e]; w1[e] = cw[MIXC + 8 * lane + e]; w2[e] = cw[2 * MIXC + 8 * lane + e]; gn[e] = sg[8 * lane + e]; }
        for (int mb = gw; mb < M; mb += 2 * NGW) {
            u32x4v raw[2][7];
#pragma unroll
            for (int q = 0; q < 2; ++q) { const int m = (mb + q * NGW < M) ? mb + q * NGW : mb; const int t = m & (T - 1);
                const bf16* pr = Pp + (size_t)m * NP + PC0 + 8 * lane;
                const bf16* p1 = (t >= 1) ? pr - NP : pr; const bf16* p2 = (t >= 2) ? pr - 2 * NP : pr;
                raw[q][0] = *(const u32x4v*)pr; raw[q][1] = *(const u32x4v*)(pr + 512); raw[q][2] = *(const u32x4v*)(pr + 1024);
                raw[q][3] = *(const u32x4v*)(p1 + 512); raw[q][4] = *(const u32x4v*)(p1 + 1024); raw[q][5] = *(const u32x4v*)(p2 + 512); raw[q][6] = *(const u32x4v*)(p2 + 1024); }
#pragma unroll
            for (int q = 0; q < 2; ++q) { const int m = mb + q * NGW; if (m >= M) break; const int t = m & (T - 1);
                float gb[8], c0[8], h0[8], c1[8], h1[8], c2[8], h2[8];
                unpack8(raw[q][0], gb); unpack8(raw[q][1], c0); unpack8(raw[q][2], h0); unpack8(raw[q][3], c1); unpack8(raw[q][4], h1); unpack8(raw[q][5], c2); unpack8(raw[q][6], h2);
                const float k1 = (t >= 1) ? 1.f : 0.f, k2 = (t >= 2) ? 1.f : 0.f;
                float y[8], s = 0.f;
#pragma unroll
                for (int e = 0; e < 8; ++e) { y[e] = gb[e] * (w0[e] * k2 * (c2[e] * h2[e]) + w1[e] * k1 * (c1[e] * h1[e]) + w2[e] * (c0[e] * h0[e])); s += y[e] * y[e]; }
                s += dppf<0xB1>(s); s += dppf<0x4E>(s); s += dppf<0x141>(s);
                const float inv = rsqrtf(s * (1.f / 64.f) + RMS_EPS);
                u32x4v o; o.x = pk2(y[0] * inv * gn[0], y[1] * inv * gn[1]); o.y = pk2(y[2] * inv * gn[2], y[3] * inv * gn[3]);
                o.z = pk2(y[4] * inv * gn[4], y[5] * inv * gn[5]); o.w = pk2(y[6] * inv * gn[6], y[7] * inv * gn[7]);
                *(u32x4v*)(MIX + (size_t)m * D + 1536 + 8 * lane) = o; }
        }
    }
    {
        const float* mu = P.in[I_MU] + (size_t)l * 3520 + 3072;
        const int q0 = 8 * lane; float muv[8];
#pragma unroll
        for (int e = 0; e < 8; ++e) muv[e] = (q0 < 448) ? mu[q0 + e] : 0.f;
        for (int mb = gw; mb < M; mb += 4 * NGW) {
            u32x4v rc[4], rp[4];
#pragma unroll
            for (int q = 0; q < 4; ++q) { const int m = (mb + q * NGW < M) ? mb + q * NGW : mb; const int t = m & (T - 1);
                const bf16* pr = Pp + (size_t)m * NP + RW0 + 3072 + ((q0 < 448) ? q0 : 0);
                rc[q] = *(const u32x4v*)pr; rp[q] = *(const u32x4v*)((t >= 1) ? pr - NP : pr); }
#pragma unroll
            for (int q = 0; q < 4; ++q) { const int m = mb + q * NGW; if (m >= M) break; const int t = m & (T - 1);
                u32x4v o = (u32x4v){0u, 0u, 0u, 0u};
                if (q0 < 448) { float c[8], pv[8], f[8];
                    unpack8(rc[q], c); unpack8(rp[q], pv);
                    const float k1 = (t >= 1) ? 1.f : 0.f;
#pragma unroll
                    for (int e = 0; e < 8; ++e) { const float x = c[e] + (pv[e] * k1 - c[e]) * muv[e];
                        f[e] = (q0 < 96) ? tanhf(x) : ((q0 < 192) ? x : sigmoidf_(x)); }
                    o.x = pk2(f[0], f[1]); o.y = pk2(f[2], f[3]); o.z = pk2(f[4], f[5]); o.w = pk2(f[6], f[7]); }
                *(u32x4v*)(AL + (size_t)m * KLORA + q0) = o; }
        }
    }
}

__device__ __forceinline__ float swap16_sum(float v) {
    float a = v, b = v;
    asm volatile("s_nop 1\n\tv_permlane16_swap_b32 %0, %1" : "+v"(a), "+v"(b));
    return a + b;
}
__device__ __forceinline__ float swap32_sum(float v) {
    float a = v, b = v;
    asm volatile("s_nop 1\n\tv_permlane32_swap_b32 %0, %1" : "+v"(a), "+v"(b));
    return a + b;
}
struct E2Tok { float r, v, decay, a, kkr, kmod; };
struct E2Raw { float r0, k0, v0, wl, al; };
__device__ __forceinline__ E2Raw e2_load(const bf16* Pp, const bf16* LO, int m, int c) {
    const bf16* pr = Pp + (size_t)m * NP + RW0; const bf16* lo = LO + (size_t)m * NLORA;
    E2Raw w; w.r0 = bf2f(pr[c]); w.k0 = bf2f(pr[1024 + c]); w.v0 = bf2f(pr[2048 + c]); w.wl = bf2f(lo[c]); w.al = bf2f(lo[1024 + c]); return w;
}
__device__ __forceinline__ E2Tok e2_token(const E2Raw& w, float& r1, float& k1, float& v1, float mur, float muk, float muv, float w0c, float a0c, float kkc, float kac) {
    const float r0 = w.r0, k0 = w.k0, v0 = w.v0, wl = w.wl, al = w.al;
    E2Tok o;
    o.r = r0 + (r1 - r0) * mur; const float k = k0 + (k1 - k0) * muk; o.v = v0 + (v1 - v0) * muv;
    r1 = r0; k1 = k0; v1 = v0;
    const float z = -(w0c + wl);
    const float sp = fmaxf(z, 0.f) + __logf(1.f + __expf(-fabsf(z)));
    o.decay = __expf(-__expf(-sp - 0.5f));
    o.a = __builtin_amdgcn_rcpf(1.f + __expf(-(a0c + al)));
    o.kkr = k * kkc;
    o.kmod = k * (1.f + (o.a - 1.f) * kac);
    return o;
}
__device__ __forceinline__ float sum4(float q0, float q1, float q2, float q3, bool o1, bool o2) {
    const float u01 = (o1 ? q1 : q0) + dppf<0xB1>(o1 ? q0 : q1);
    const float u23 = (o1 ? q3 : q2) + dppf<0xB1>(o1 ? q2 : q3);
    float u = (o2 ? u23 : u01) + dppf<0x4E>(o2 ? u01 : u23);
    u += dppf<0x124>(u); u += dppf<0x128>(u);
    u = swap16_sum(u); u = swap32_sum(u);
    return u;
}
__device__ __forceinline__ void phase_e2(const Params& P, int l, int wave, int lane) {
    const int gw = blockIdx.x * NWAVES + wave, NGW = gridDim.x * NWAVES;
    const bf16* Pp = (const bf16*)(P.ws + WS_P);
    const bf16* LO = (const bf16*)(P.ws + WS_LORA);
    float* SI = (float*)(P.ws + WS_SCANIN); float* SV = (float*)(P.ws + WS_SV); float* SC = (float*)(P.ws + WS_SC); float* SB = (float*)(P.ws + WS_SB);
    const float* mu = P.in[I_MU] + (size_t)l * 3520;
    const bool o1 = (lane & 1) != 0, o2 = (lane & 2) != 0;
    for (int wt = gw; wt < (M / 64) * 16; wt += NGW) {
        const int h = wt & 15, m0 = (wt >> 4) * 64, c = h * 64 + lane, b = m0 >> 12;
        const float mur = mu[c], muk = mu[1024 + c], muv = mu[2048 + c];
        const float w0c = P.in[I_W0][l * MIXB + c], a0c = P.in[I_A0][l * MIXB + c], kkc = P.in[I_KK][l * MIXB + c], kac = P.in[I_KA][l * MIXB + c], rkc = P.in[I_RK][l * MIXB + c];
        float r1 = 0.f, k1 = 0.f, v1 = 0.f;
        if ((m0 & (T - 1)) != 0) { const bf16* pp = Pp + (size_t)(m0 - 1) * NP + RW0; r1 = bf2f(pp[c]); k1 = bf2f(pp[1024 + c]); v1 = bf2f(pp[2048 + c]); }
        const size_t row0 = (size_t)(b * 16 + h) * T + (m0 & (T - 1));
        E2Raw pa0 = e2_load(Pp, LO, m0, c), pa1 = e2_load(Pp, LO, m0 + 1, c), pb0 = e2_load(Pp, LO, m0 + 2, c), pb1 = e2_load(Pp, LO, m0 + 3, c);
        for (int i = 0; i < 64; i += 2) {
            const int m = m0 + i;
            const int mn = (i + 4 < 64) ? m + 4 : m;
            const E2Raw pc0 = e2_load(Pp, LO, mn, c), pc1 = e2_load(Pp, LO, mn + 1, c);
            const E2Tok A = e2_token(pa0, r1, k1, v1, mur, muk, muv, w0c, a0c, kkc, kac);
            const E2Tok B = e2_token(pa1, r1, k1, v1, mur, muk, muv, w0c, a0c, kkc, kac);
            pa0 = pb0; pa1 = pb1; pb0 = pc0; pb1 = pc1;
            const float ka1 = A.kkr * A.a, ka2 = B.kkr * B.a, w2r2 = B.decay * B.r;
            const float uA = sum4(A.kkr * A.kkr, B.kkr * B.kkr, A.r * A.kmod * rkc, B.r * B.kmod * rkc, o1, o2);
            const float uB = sum4(ka1 * B.kkr, ka1 * A.r, ka1 * w2r2, ka2 * B.r, o1, o2);
            const float uC = sum4(A.kmod * B.kkr, A.kmod * A.r, A.kmod * w2r2, B.kmod * B.r, o1, o2);
            const float in1 = 1.f / fmaxf(sqrtf(dppf<0x00>(uA)), 1e-12f), in2 = 1.f / fmaxf(sqrtf(dppf<0x55>(uA)), 1e-12f);
            const float kk1 = A.kkr * in1, kk2 = B.kkr * in2, bs1 = kk1 * A.a, bs2 = kk2 * B.a, w12 = A.decay * B.decay;
            float* o = SI + ((row0 + i) >> 1) * 576;
            o[lane] = -kk1; o[64 + lane] = -(A.decay * kk2); o[128 + lane] = A.decay * A.r; o[192 + lane] = w12 * B.r; o[256 + lane] = w12;
            o[320 + lane] = bs1 * B.decay; o[384 + lane] = A.kmod * B.decay; o[448 + lane] = bs2; o[512 + lane] = B.kmod;
            SV[(row0 + i) * 64 + lane] = A.v; SV[(row0 + i + 1) * 64 + lane] = B.v;
            if (lane < 4) {
                const float sB = (lane == 0) ? -(in1 * in2) : ((lane == 3) ? in2 : in1);
                const float sC = (lane == 0) ? -in2 : 1.f;
                float* sc = SC + ((row0 + i) >> 1) * 12;
                const int ib = (lane == 0) ? 0 : ((lane == 1) ? 4 : ((lane == 2) ? 8 : 10));
                sc[ib] = uB * sB; sc[ib + 1] = uC * sC;
                if (lane < 2) { sc[2 + 4 * lane] = 0.f; sc[3 + 4 * lane] = 0.f; }
                if (lane >= 2) SB[(m + lane - 2) * 16 + h] = uA;
            }
        }
    }
}

constexpr int SCH = 32;
constexpr int SVOFF = (SCH / 2) * 576, SCOFF = SVOFF + SCH * 8;
constexpr int SBUF_F = SCOFF + (SCH / 2) * 12;
struct ScanRegs { f32x4 r[9]; f32x4 e; };
__device__ __forceinline__ void scan_issue(ScanRegs& R, const float* gvec, const float* gv, const float* gsc, int c, int lt) {
    const char* src = (const char*)(gvec + (size_t)c * (SCH / 2) * 576);
    const unsigned loff = (unsigned)lt * 16u;
#pragma unroll
    for (int i = 0; i < 9; ++i) R.r[i] = *(const f32x4*)(src + (size_t)i * 4096 + loff);
    R.e = (f32x4){0.f, 0.f, 0.f, 0.f};
    if (lt < 64) { const int tt = lt >> 1, part = lt & 1; R.e = *(const f32x4*)(gv + (size_t)(c * SCH + tt) * 64 + part * 4); }
    else if (lt < 112) { R.e = ((const f32x4*)(gsc + (size_t)c * (SCH / 2) * 12))[lt - 64]; }
}
__device__ __forceinline__ void scan_commit(const ScanRegs& R, LAS float* buf, int lt) {
#pragma unroll
    for (int i = 0; i < 9; ++i) ((LAS f32x4*)buf)[lt + 256 * i] = R.r[i];
    if (lt < 112) ((LAS f32x4*)(buf + SVOFF))[lt] = R.e;
}
constexpr int YST_OFF_B = 2 * SBUF_F * 4 + 4 * 4352;
static_assert(YST_OFF_B % 16 == 0 && YST_OFF_B + 2048 <= LDS_BAR_OFF, "scan LDS map");
__device__ __forceinline__ void scan_flush_y(LAS const float* ys, float* dst, int lane) {
    const int t = lane >> 1, hh = lane & 1;
    *(f32x4*)(dst + (size_t)t * MIXB + hh * 4) = *(LAS const f32x4*)(ys + t * 8 + hh * 4);
}
__device__ __forceinline__ void phase_scan(const Params& P, int l, LAS unsigned char* lds, int wave, int lane) {
    const float* SI = (const float*)(P.ws + WS_SCANIN); const float* SV = (const float*)(P.ws + WS_SV); const float* SC = (const float*)(P.ws + WS_SC);
    float* YS = (float*)(P.ws + WS_YS);
    const int tid = threadIdx.x;
#ifndef SCAN_ODD_LOADERS
#define SCAN_ODD_LOADERS 0
#endif
    const bool is_loader = SCAN_ODD_LOADERS ? ((wave & 1) != 0) : (wave >= 4);
    const int widx = SCAN_ODD_LOADERS ? (wave >> 1) : (wave & 3), lt = widx * 64 + lane;
    for (int task = blockIdx.x; task < 256; task += gridDim.x) {
        const int x = task & 7, s = task >> 3, bh = x * 4 + (s >> 3), q = s & 7, b = bh >> 4, h = bh & 15;
        const float* gvec = SI + (size_t)bh * (T / 2) * 576;
        const float* gv = SV + (size_t)bh * T * 64 + q * 8;
        const float* gsc = SC + (size_t)bh * (T / 2) * 12;
        LAS float* buf0 = (LAS float*)lds; LAS float* buf1 = buf0 + SBUF_F;
        ScanRegs R;
        const int lw = blockIdx.x * 4 + widx, nslab = (l + 1 < L && task < (int)gridDim.x && (int)gridDim.x * 4 * (T / SCH) >= 4 * TR_PER_L) ? 4 * TR_PER_L : 0;
        LAS float* scrw = (LAS float*)(lds + 2 * SBUF_F * 4) + widx * 1088;
        TrItem sl; f32x4 sv[4]; bool have = false;
        if (is_loader) { scan_issue(R, gvec, gv, gsc, 0, lt); scan_commit(R, buf0, lt); scan_issue(R, gvec, gv, gsc, 1, lt);
            if (lw < nslab) { sl = tr_decode(P, (l + 1) * TR_PER_L + (lw >> 2)); sl.k0 += 16 * (lw & 3); tr_slab_load(sl, sv, lane); have = true; } }
        __syncthreads();
        const int cl = lane & 31, il = widx * 2 + (lane >> 5), g8 = cl >> 2, cls = cl & 3; const bool o1 = (cl & 1) != 0, o2 = (cl & 2) != 0;
        float S0 = 0.f, S1 = 0.f, yrec = 0.f;
        const int ycoef = o1 ? 8 : 4;
        float* ybase = YS + (size_t)(b * T) * MIXB + h * 64 + q * 8;
        for (int c = 0; c < T / SCH; ++c) {
            LAS const float* cur = (c & 1) ? buf1 : buf0; LAS float* nxt = (c & 1) ? buf0 : buf1;
            LAS float* yst = (LAS float*)(lds + YST_OFF_B) + (c & 1) * 256;
            if (is_loader) { if (c + 1 < T / SCH) { scan_commit(R, nxt, lt); if (c + 2 < T / SCH) scan_issue(R, gvec, gv, gsc, c + 2, lt); }
                if (c >= 1 && widx == 0) scan_flush_y((LAS const float*)(lds + YST_OFF_B) + ((c - 1) & 1) * 256, ybase + (size_t)((c - 1) * SCH) * MIXB, lane);
                if (have) tr_slab_store(sl, sv, scrw, lane);
                const int slab = (c + 1) * (int)gridDim.x * 4 + lw; have = (c + 1 < T / SCH) && (slab < nslab);
                if (have) { sl = tr_decode(P, (l + 1) * TR_PER_L + (slab >> 2)); sl.k0 += 16 * (slab & 3); tr_slab_load(sl, sv, lane); } }
            else {
#define SCAN_LD(pp, V1, V2, V3, V4, U1, U2, U3, U4, U5, v1, v2, ca, cb) \
                LAS const float* vb_##V1 = cur + (pp) * 576 + cl * 2; \
                V1 = *(LAS const f32x2v*)(vb_##V1); V2 = *(LAS const f32x2v*)(vb_##V1 + 64); V3 = *(LAS const f32x2v*)(vb_##V1 + 128); V4 = *(LAS const f32x2v*)(vb_##V1 + 192); \
                U1 = *(LAS const f32x2v*)(vb_##V1 + 256); U2 = *(LAS const f32x2v*)(vb_##V1 + 320); U3 = *(LAS const f32x2v*)(vb_##V1 + 384); U4 = *(LAS const f32x2v*)(vb_##V1 + 448); U5 = *(LAS const f32x2v*)(vb_##V1 + 512); \
                v1 = cur[SVOFF + (2 * (pp)) * 8 + il]; v2 = cur[SVOFF + (2 * (pp) + 1) * 8 + il]; \
                ca = *(LAS const f32x2v*)(cur + SCOFF + (pp) * 12); cb = *(LAS const f32x4*)(cur + SCOFF + (pp) * 12 + ycoef);
                f32x2v V1, V2, V3, V4, U1, U2, U3, U4, U5; float v1, v2; f32x2v ca; f32x4 cb;
                { SCAN_LD(0, V1, V2, V3, V4, U1, U2, U3, U4, U5, v1, v2, ca, cb) }
#pragma unroll 8
                for (int p = 0; p < SCH / 2; ++p) {
                    const int pn = (p + 1 < SCH / 2) ? p + 1 : p;
                    f32x2v nV1, nV2, nV3, nV4, nU1, nU2, nU3, nU4, nU5; float nv1, nv2; f32x2v nca; f32x4 ncb;
                    { SCAN_LD(pn, nV1, nV2, nV3, nV4, nU1, nU2, nU3, nU4, nU5, nv1, nv2, nca, ncb) }
                    const float d0 = S0 * V1[0] + S1 * V1[1], d1 = S0 * V2[0] + S1 * V2[1], d2 = S0 * V3[0] + S1 * V3[1], d3 = S0 * V4[0] + S1 * V4[1];
                    const float t0 = v1 * U3[0] + v2 * U5[0], t1 = v1 * U3[1] + v2 * U5[1];
                    const float u01 = (o1 ? d1 : d0) + dppf<0xB1>(o1 ? d0 : d1);
                    const float u23 = (o1 ? d3 : d2) + dppf<0xB1>(o1 ? d2 : d3);
                    float u = (o2 ? u23 : u01) + dppf<0x4E>(o2 ? u01 : u23);
                    u += dppf<0x124>(u); u += dppf<0x128>(u);
                    u = swap16_sum(u);
                    const float sa1 = dppf<0x00>(u);
                    const float sa2 = dppf<0x55>(u) + sa1 * ca[0] + v1 * ca[1];
                    S0 = (S0 * U1[0] + (sa1 * U2[0] + t0)) + sa2 * U4[0];
                    S1 = (S1 * U1[1] + (sa1 * U2[1] + t1)) + sa2 * U4[1];
                    const float ysel = u + sa1 * cb[0] + v1 * cb[1] + sa2 * cb[2] + v2 * cb[3];
                    yrec = ((p & 7) == g8) ? ysel : yrec;
                    if ((p & 7) == 7) { if (o2) yst[((p & 8) * 2 + 2 * g8 + (cls - 2)) * 8 + il] = yrec; }
                    V1 = nV1; V2 = nV2; V3 = nV3; V4 = nV4; U1 = nU1; U2 = nU2; U3 = nU3; U4 = nU4; U5 = nU5; v1 = nv1; v2 = nv2; ca = nca; cb = ncb;
                }
#undef SCAN_LD
            }
            asm volatile("s_waitcnt lgkmcnt(0)" ::: "memory"); __builtin_amdgcn_s_barrier(); asm volatile("" ::: "memory");
        }
        if (is_loader && widx == 0) scan_flush_y((LAS const float*)(lds + YST_OFF_B) + ((T / SCH - 1) & 1) * 256, ybase + (size_t)((T / SCH - 1) * SCH) * MIXB, lane);
    }
}

__device__ __forceinline__ void phase_e3(const Params& P, int l, int wave, int lane) {
    const int gw = blockIdx.x * NWAVES + wave, NGW = gridDim.x * NWAVES;
    const float* YS = (const float*)(P.ws + WS_YS); const bf16* LO = (const bf16*)(P.ws + WS_LORA);
    const float* SV = (const float*)(P.ws + WS_SV); const float* SB = (const float*)(P.ws + WS_SB);
    bf16* MIX = (bf16*)(P.ws + WS_MIX);
    const bool o1 = (lane & 1) != 0, o2 = (lane & 2) != 0;
    for (int wt = gw; wt < (M / 64) * 16; wt += NGW) {
        const int h = wt & 15, m0 = (wt >> 4) * 64, c = h * 64 + lane, b = m0 >> 12;
        const float lnw = P.in[I_LNW][l * MIXB + c], lnb = P.in[I_LNB][l * MIXB + c];
        const size_t row0 = (size_t)(b * 16 + h) * T + (m0 & (T - 1));
        for (int i = 0; i < 64; i += 8) {
            float y[8], v[8], g[8], sb[8];
#pragma unroll
            for (int e = 0; e < 8; ++e) { const int m = m0 + i + e;
                y[e] = YS[(size_t)m * MIXB + c]; v[e] = SV[(row0 + i + e) * 64 + lane]; g[e] = bf2f(LO[(size_t)m * NLORA + 2048 + c]); sb[e] = SB[m * 16 + h]; }
#pragma unroll
            for (int e = 0; e < 8; e += 2) {
                const float u = sum4(y[e], y[e] * y[e], y[e + 1], y[e + 1] * y[e + 1], o1, o2);
                const float s0 = dppf<0x00>(u), q0 = dppf<0x55>(u), s1 = dppf<0xAA>(u), q1 = dppf<0xFF>(u);
                const float mean0 = s0 * (1.f / 64.f), mean1 = s1 * (1.f / 64.f);
                const float var0 = fmaxf(q0 * (1.f / 64.f) - mean0 * mean0, 0.f), var1 = fmaxf(q1 * (1.f / 64.f) - mean1 * mean1, 0.f);
                const float yn0 = (y[e] - mean0) * rsqrtf(var0 + LNX_EPS) * lnw + lnb, yn1 = (y[e + 1] - mean1) * rsqrtf(var1 + LNX_EPS) * lnw + lnb;
                MIX[(size_t)(m0 + i + e) * D + 512 + c] = (bf16)f2bf((yn0 + sb[e] * v[e]) * g[e]);
                MIX[(size_t)(m0 + i + e + 1) * D + 512 + c] = (bf16)f2bf((yn1 + sb[e + 1] * v[e + 1]) * g[e + 1]);
            }
        }
    }
}

template <bool IN_F32, bool OUT_F32>
__device__ __forceinline__ void phase_norm(const void* xin_, void* xout_, const bf16* Y, const float* g1, const float* g2, bf16* XB, int wave, int lane) {
    const int gw = blockIdx.x * NWAVES + wave, NGW = gridDim.x * NWAVES;
    const float* xin32 = (const float*)xin_; const bf16* xin16 = (const bf16*)xin_;
    f32x4 yv[8], xv[8];
    u32x2v yr[8], xr[8];
    if (gw < M) {
#pragma unroll
        for (int j = 0; j < 8; ++j) { yr[j] = ((const u32x2v*)(Y + (size_t)gw * D))[lane + 64 * j];
            if (IN_F32) xv[j] = ((const f32x4*)(xin32 + (size_t)gw * D))[lane + 64 * j]; else xr[j] = ((const u32x2v*)(xin16 + (size_t)gw * D))[lane + 64 * j]; }
    }
    for (int m = gw; m < M; m += NGW) {
        const int mn = (m + NGW < M) ? m + NGW : m;
        u32x2v ny[8], nxr[8]; f32x4 nx[8];
#pragma unroll
        for (int j = 0; j < 8; ++j) { ny[j] = ((const u32x2v*)(Y + (size_t)mn * D))[lane + 64 * j];
            if (IN_F32) nx[j] = ((const f32x4*)(xin32 + (size_t)mn * D))[lane + 64 * j]; else nxr[j] = ((const u32x2v*)(xin16 + (size_t)mn * D))[lane + 64 * j]; }
#pragma unroll
        for (int j = 0; j < 8; ++j) { yv[j] = (f32x4){lo16(yr[j].x), hi16(yr[j].x), lo16(yr[j].y), hi16(yr[j].y)};
            if (!IN_F32) xv[j] = (f32x4){lo16(xr[j].x), hi16(xr[j].x), lo16(xr[j].y), hi16(xr[j].y)}; }
        float s = 0.f;
#pragma unroll
        for (int j = 0; j < 8; ++j) s += (yv[j][0] * yv[j][0] + yv[j][1] * yv[j][1]) + (yv[j][2] * yv[j][2] + yv[j][3] * yv[j][3]);
        const float inv = rsqrtf(wave_sum(s) * (1.f / D) + RMS_EPS);
        float s2 = 0.f;
#pragma unroll
        for (int j = 0; j < 8; ++j) { const f32x4 g = ((const f32x4*)g1)[lane + 64 * j];
            yv[j] = xv[j] + yv[j] * inv * g; s2 += (yv[j][0] * yv[j][0] + yv[j][1] * yv[j][1]) + (yv[j][2] * yv[j][2] + yv[j][3] * yv[j][3]);
            if (OUT_F32) ((f32x4*)((float*)xout_ + (size_t)m * D))[lane + 64 * j] = yv[j];
            else { u32x2v o; o.x = pk2(yv[j][0], yv[j][1]); o.y = pk2(yv[j][2], yv[j][3]); ((u32x2v*)((bf16*)xout_ + (size_t)m * D))[lane + 64 * j] = o; } }
        if (g2) {
            const float inv2 = rsqrtf(wave_sum(s2) * (1.f / D) + RMS_EPS);
#pragma unroll
            for (int j = 0; j < 8; ++j) { const f32x4 g = ((const f32x4*)g2)[lane + 64 * j];
                u32x2v o; o.x = pk2(yv[j][0] * inv2 * g[0], yv[j][1] * inv2 * g[1]); o.y = pk2(yv[j][2] * inv2 * g[2], yv[j][3] * inv2 * g[3]);
                ((u32x2v*)(XB + (size_t)m * D))[lane + 64 * j] = o; }
        }
#pragma unroll
        for (int j = 0; j < 8; ++j) { yr[j] = ny[j]; if (IN_F32) xv[j] = nx[j]; else xr[j] = nxr[j]; }
    }
}

#define XB_TMO      128
#define XB_XCNT(j)  (256  + 64 * (j))
#define XB_XSUB(j)  (1280 + 64 * (j))
#define XB_XGEN(j)  (2304 + 64 * (j))
#define XB_TOP      3328
#define XB_TOPGEN   3392
#define XCD_BAR_WORDS 3456
#define XB_SPIN_CAP (1u << 18)

__device__ __forceinline__ unsigned xb_ld(unsigned* p)              { return __hip_atomic_load(p, __ATOMIC_RELAXED, __HIP_MEMORY_SCOPE_AGENT); }
__device__ __forceinline__ unsigned xb_add(unsigned* p, unsigned v) { return __hip_atomic_fetch_add(p, v, __ATOMIC_RELAXED, __HIP_MEMORY_SCOPE_AGENT); }
__device__ __forceinline__ unsigned xb_xcc_id() { return (unsigned)__builtin_amdgcn_s_getreg((3 << 11) | 20) & 0xFu; }
#define XB_SPIN(cond, bar) do { unsigned _sp = 0; while (cond) { __builtin_amdgcn_s_sleep(0); \
    if ((++_sp & 255u) == 0u) { if (xb_ld(&(bar)[XB_TMO])) break; if (_sp > XB_SPIN_CAP) { atomicAdd(&(bar)[XB_TMO], 1u); break; } } } } while (0)

struct XcdBarrier {
    unsigned* bar; unsigned x;
    volatile LAS unsigned* st;
};

__device__ __forceinline__ XcdBarrier xcd_barrier_post(unsigned* bar, volatile LAS unsigned* st) {
    XcdBarrier b; b.bar = bar; b.x = xb_xcc_id(); b.st = st;
    if (threadIdx.x == 0) (void)xb_add(&bar[XB_XCNT(b.x)], 1u);
    return b;
}
__device__ __forceinline__ void xcd_barrier_complete(unsigned* bar, unsigned x, unsigned& nloc, unsigned& nx) {
    const unsigned G = gridDim.x * gridDim.y * gridDim.z;
    unsigned sum, cnt, mine, sp = 0u;
    for (;;) {
        sum = 0u; cnt = 0u; mine = 0u;
#pragma unroll
        for (unsigned j = 0; j < 16; ++j) { const unsigned c = xb_ld(&bar[XB_XCNT(j)]); sum += c; cnt += (c > 0u) ? 1u : 0u; mine = (j == x) ? c : mine; }
        if (sum == G) break;
        __builtin_amdgcn_s_sleep(1);
        if ((++sp & 255u) == 0u) { if (xb_ld(&bar[XB_TMO])) break; if (sp > XB_SPIN_CAP) { atomicAdd(&bar[XB_TMO], 1u); break; } }
    }
    nloc = mine > 0u ? mine : 1u; nx = cnt > 0u ? cnt : 1u;
}

__device__ __forceinline__ void xcd_barrier(const XcdBarrier& b) {
    asm volatile("s_waitcnt vmcnt(0)" ::: "memory");
    __syncthreads();
    if (threadIdx.x == 0) {
        unsigned* bar = b.bar;
        __builtin_amdgcn_s_waitcnt(0);
        unsigned nloc = b.st[0], nx = b.st[1];
        if (nloc == 0u) { xcd_barrier_complete(bar, b.x, nloc, nx); b.st[0] = nloc; b.st[1] = nx; }
        const unsigned old = xb_add(&bar[XB_XSUB(b.x)], 1u);
        const unsigned gen = old / nloc;
        if (old + 1u == (gen + 1u) * nloc) {
            __builtin_amdgcn_fence(__ATOMIC_RELEASE, "agent");
            asm volatile("s_waitcnt vmcnt(0)" ::: "memory");
            const unsigned og = xb_add(&bar[XB_TOP], 1u);
            const unsigned tg = og / nx;
            if (og + 1u == (tg + 1u) * nx) xb_add(&bar[XB_TOPGEN], 1u);
            else XB_SPIN(xb_ld(&bar[XB_TOPGEN]) == tg, bar);
            __builtin_amdgcn_fence(__ATOMIC_ACQUIRE, "agent");
            xb_add(&bar[XB_XGEN(b.x)], 1u);
            asm volatile("s_waitcnt vmcnt(0)" ::: "memory");
        } else {
            XB_SPIN(xb_ld(&bar[XB_XGEN(b.x)]) == gen, bar);
            __builtin_amdgcn_fence(__ATOMIC_ACQUIRE, "agent");
            asm volatile("s_waitcnt vmcnt(0)" ::: "memory");
        }
    }
    __syncthreads();
}


template <class Epi> __device__ __forceinline__ void run_gemm(LAS unsigned char* lds, const bf16* A, const bf16* Bt, int N, int K, const Epi& E, int wnt = 0, int wks = 0x7fffffff, int wko = 0) {
    pg8::Gemm g{A, Bt, M, N, K, wnt, wks, wko}; pg8::StaticOrder S; S.init(M, N, (int)gridDim.x, (int)blockIdx.x);
    pg8::gemm_phase<Epi, pg8::StaticOrder, true, true>(lds, g, S, E);
}

__global__ void __launch_bounds__(NWAVES * 64, 2) trunk_fwd(Params P) {
    extern __shared__ __attribute__((aligned(16))) unsigned char lds_raw[];
    LAS unsigned char* lds = (LAS unsigned char*)lds_raw;
    cg::grid_group grid = cg::this_grid();
    if (threadIdx.x < 4) ((LAS unsigned*)(lds + LDS_BAR_OFF))[threadIdx.x] = 0u;
    __syncthreads();
    const XcdBarrier xbar = xcd_barrier_post((unsigned*)(P.ws + WS_CTL), (volatile LAS unsigned*)(lds + LDS_BAR_OFF));
    if (P.ph_hi - P.ph_lo > 1) grid.sync();
    unsigned char* ws = P.ws;
    for (int ph = P.ph_lo; ph < P.ph_hi; ++ph) {
        int tid = threadIdx.x; asm volatile("" : "+v"(tid));
        const int lane = tid & 63, wave = __builtin_amdgcn_readfirstlane(tid >> 6);
        if (ph == 0) phase0(P, lds, wave, lane);
        else {
            const int l = (ph - 1) / NPH, k = (ph - 1) % NPH;
            if (k == 0 || k == 8 || k == 2 || k == 6 || k == 9) {
                const bf16* A = (k == 0 || k == 8) ? (const bf16*)(ws + WS_XB) : ((k == 2) ? (const bf16*)(ws + WS_ALORA) : ((k == 6) ? (const bf16*)(ws + WS_MIX) : (const bf16*)(ws + WS_U)));
                const bf16* Bt = (k == 0) ? (const bf16*)(ws + WS_WIN) + (size_t)l * NP * D : ((k == 8) ? (const bf16*)(ws + WS_WUP) + (size_t)l * FF * D
                               : ((k == 2) ? (const bf16*)(ws + WS_WLORA) + (size_t)l * NLORA * KLORA : ((k == 6) ? (const bf16*)(ws + WS_WOUT) + (size_t)l * D * D : (const bf16*)(ws + WS_WDN) + (size_t)l * D * FF)));
                const int N = (k == 0) ? NP : ((k == 8) ? FF : ((k == 2) ? NLORA : D)), K = (k == 2) ? KLORA : ((k == 9) ? FF : D);
                bf16* O = (bf16*)(ws + ((k == 0) ? WS_P : ((k == 8) ? WS_U : ((k == 2) ? WS_LORA : WS_Y))));
                pg8::EpiBf16 E{O, N, (k == 8) ? 1 : 0};
                run_gemm(lds, A, Bt, N, K, E, (k == 2) ? 4 : 0, (k == 2) ? 8 : 0x7fffffff, (k == 2) ? 192 : 0);
            } else if (k == 1) phase_e1(P, l, lds, wave, lane);
            else if (k == 3) phase_e2(P, l, wave, lane);
            else if (k == 4) phase_scan(P, l, lds, wave, lane);
            else if (k == 5) phase_e3(P, l, wave, lane);
            else if (k == 7) { if (l == 0) phase_norm<true, false>(P.in[I_X], ws + WS_XR, (const bf16*)(ws + WS_Y), P.in[I_NMIXPOST] + l * D, P.in[I_NMLPPRE] + l * D, (bf16*)(ws + WS_XB), wave, lane);
                               else phase_norm<false, false>(ws + WS_XR, ws + WS_XR, (const bf16*)(ws + WS_Y), P.in[I_NMIXPOST] + l * D, P.in[I_NMLPPRE] + l * D, (bf16*)(ws + WS_XB), wave, lane); }
            else   { if (l + 1 < L) phase_norm<false, false>(ws + WS_XR, ws + WS_XR, (const bf16*)(ws + WS_Y), P.in[I_NMLPPOST] + l * D, P.in[I_NMIXPRE] + (l + 1) * D, (bf16*)(ws + WS_XB), wave, lane);
                                 else phase_norm<false, true>(ws + WS_XR, P.out, (const bf16*)(ws + WS_Y), P.in[I_NMLPPOST] + l * D, nullptr, (bf16*)(ws + WS_XB), wave, lane); }
        }
        if (ph + 1 < P.ph_hi) xcd_barrier(xbar);
        else if (false) {
            asm volatile("s_waitcnt vmcnt(0) lgkmcnt(0)" ::: "memory");
            __syncthreads();
            if (tid == 0) { __builtin_amdgcn_fence(__ATOMIC_RELEASE, "agent"); asm volatile("s_waitcnt vmcnt(0)" ::: "memory"); }
            grid.sync();
            if (tid == 0) { __builtin_amdgcn_fence(__ATOMIC_ACQUIRE, "agent"); asm volatile("s_waitcnt vmcnt(0)" ::: "memory"); }
            __syncthreads();
        }
    }
}

#pragma clang attribute pop
#ifndef MULTI_LAUNCH
#define MULTI_LAUNCH 0
#endif
extern "C" void kernel_launch(void* const* d_in, const int* in_sizes, int n_in, void* d_out, int out_size, void* d_ws, size_t ws_size, hipStream_t stream) {
    static int grid = 0;
    if (grid == 0) {
        int dev = 0, cus = 0, per_cu = 0;
        (void)hipGetDevice(&dev);
        (void)hipDeviceGetAttribute(&cus, hipDeviceAttributeMultiprocessorCount, dev);
        if (hipFuncSetAttribute((const void*)trunk_fwd, hipFuncAttributeMaxDynamicSharedMemorySize, LDS_BYTES) != hipSuccess) fprintf(stderr, "kernel_launch: hipFuncSetAttribute failed\n");
        if (hipOccupancyMaxActiveBlocksPerMultiprocessor(&per_cu, (const void*)trunk_fwd, NWAVES * 64, LDS_BYTES) != hipSuccess || per_cu < 1) { fprintf(stderr, "kernel_launch: occupancy query gave %d\n", per_cu); per_cu = 1; }
        (void)hipGetLastError();
        grid = cus * per_cu;
        if (n_in != 26 || ws_size < WS_END) fprintf(stderr, "kernel_launch: unexpected n_in %d / ws_size %zu (need %zu)\n", n_in, ws_size, (size_t)WS_END);
    }
    (void)hipMemsetAsync((char*)d_ws + WS_CTL, 0, CTL_BYTES, stream);
    Params p{};
    for (int i = 0; i < 26; ++i) p.in[i] = (const float*)d_in[i];
    p.out = (float*)d_out; p.ws = (unsigned char*)d_ws;
    const int nph = 1 + L * NPH;
#if MULTI_LAUNCH
    for (int ph = 0; ph < nph; ++ph) { p.ph_lo = ph; p.ph_hi = ph + 1; hipLaunchKernelGGL(trunk_fwd, dim3(grid), dim3(NWAVES * 64), LDS_BYTES, stream, p); }
#else
    p.ph_lo = 0; p.ph_hi = nph;
    void* args[] = {&p};
    hipError_t e = hipLaunchCooperativeKernel((const void*)trunk_fwd, dim3(grid), dim3(NWAVES * 64), args, LDS_BYTES, stream);
    if (e != hipSuccess) fprintf(stderr, "cooperative launch failed: %s (grid %d)\n", hipGetErrorString(e), grid);
#endif
}
```
